# Optimizing an MI355X kernel written in HIP

```python
import math
import jax, jax.numpy as jnp
from jax import lax
import numpy as np

D_MODEL = 1024
BATCH = 8
SEQ = 4096
DEPTH = 1

CHUNK = 64
D_FF = 2816
POOL_WIDTH = D_MODEL // 2
POOL_WINDOWS = (2, 4, 8, 16)
N_POOL_GROUPS = len(POOL_WINDOWS)
POOL_GROUP = POOL_WIDTH // N_POOL_GROUPS
SSM_WIDTH = D_MODEL // 2
SSM_GROUP = 16
N_SSM_GROUPS = SSM_WIDTH // SSM_GROUP
SSM_STATE = 64
N_SUBLAYERS = 3
N_MOD = 3
IN_WIDTH = POOL_WIDTH + SSM_WIDTH + 2 * D_MODEL
EPS = 1e-6
DT_MIN = 1e-3
DT_MAX = 1e-1

kernel_name = "hybrid_pool_s5_macaron_adaln"


def rms_norm(x, g):
    xf = x.astype(jnp.float32)
    y = xf * lax.rsqrt(jnp.mean(xf * xf, axis=-1, keepdims=True) + EPS)
    return (y * g.astype(jnp.float32)).astype(x.dtype)


def modulate(h, shift, scale):
    return h * (1 + scale[:, None, :]) + shift[:, None, :]


def swiglu(h, w_in, w_out):
    a, b = jnp.split(h @ w_in, 2, axis=-1)
    return (jax.nn.silu(a) * b) @ w_out


def multiscale_pool(u, pool_w, pool_b, pool_scale):
    B, T, _ = u.shape
    ug = u.reshape(B, T, N_POOL_GROUPS, POOL_GROUP)
    cs = jnp.cumsum(ug.astype(jnp.float32), axis=1)
    pos = jnp.arange(T)
    means = []
    for k, w in enumerate(POOL_WINDOWS):
        csk = cs[:, :, k]
        prev = jnp.pad(csk, ((0, 0), (w, 0), (0, 0)))[:, :T]
        cnt = jnp.minimum(pos + 1, w).astype(jnp.float32)[None, :, None]
        means.append((csk - prev) / cnt)
    mean = jnp.stack(means, axis=2).astype(u.dtype)
    z = mean - ug
    z = jnp.einsum('btgc,gcd->btgd', z, pool_w) + pool_b.reshape(N_POOL_GROUPS, POOL_GROUP)
    return z.reshape(B, T, POOL_WIDTH) * pool_scale


def _ssm_combine(left, right):
    ar_l, ai_l, br_l, bi_l = left
    ar_r, ai_r, br_r, bi_r = right
    ar = ar_r * ar_l - ai_r * ai_l
    ai = ar_r * ai_l + ai_r * ar_l
    br = ar_r * br_l - ai_r * bi_l + br_r
    bi = ar_r * bi_l + ai_r * br_l + bi_r
    return (ar, ai, br, bi)


def s5_mixer(u, lam_re_log, lam_im, log_dt, b_re, b_im, c_re, c_im, d_skip, w_glu, b_glu):
    B, T, _ = u.shape
    f32 = jnp.float32
    uf = u.astype(f32).reshape(B, T, N_SSM_GROUPS, SSM_GROUP)
    lr = -jnp.exp(lam_re_log.astype(f32))
    li = lam_im.astype(f32)
    dt = jnp.exp(log_dt.astype(f32))[:, None]
    mag = jnp.exp(lr * dt)
    ang = li * dt
    ab_re = mag * jnp.cos(ang)
    ab_im = mag * jnp.sin(ang)
    num_re = ab_re - 1.0
    num_im = ab_im
    den = lr * lr + li * li
    f_re = (num_re * lr + num_im * li) / den
    f_im = (num_im * lr - num_re * li) / den
    br = b_re.astype(f32)
    bi = b_im.astype(f32)
    bb_re = f_re[..., None] * br - f_im[..., None] * bi
    bb_im = f_re[..., None] * bi + f_im[..., None] * br
    bu_re = jnp.einsum('btgh,gnh->btgn', uf, bb_re)
    bu_im = jnp.einsum('btgh,gnh->btgn', uf, bb_im)
    a_re = jnp.broadcast_to(ab_re[None, None], (1, T, N_SSM_GROUPS, SSM_STATE))
    a_im = jnp.broadcast_to(ab_im[None, None], (1, T, N_SSM_GROUPS, SSM_STATE))
    _, _, s_re, s_im = lax.associative_scan(_ssm_combine, (a_re, a_im, bu_re, bu_im), axis=1)
    y = (jnp.einsum('btgn,ghn->btgh', s_re, c_re.astype(f32))
         - jnp.einsum('btgn,ghn->btgh', s_im, c_im.astype(f32)))
    y = y.reshape(B, T, SSM_WIDTH) + d_skip.astype(f32) * uf.reshape(B, T, SSM_WIDTH)
    y = jax.nn.gelu(y.astype(u.dtype), approximate=False)
    val, gate = jnp.split(y @ w_glu + b_glu, 2, axis=-1)
    return val * jax.nn.sigmoid(gate)


def setup_inputs(seed: int = 0) -> dict:
    key = jax.random.key(seed)
    ks = jax.random.split(key, 32)
    L, D, F = DEPTH, D_MODEL, D_FF
    G, H, N = N_SSM_GROUPS, SSM_GROUP, SSM_STATE
    nrm = lambda k, shape, s: jax.random.normal(k, shape, jnp.float32) * s
    n_idx = jnp.arange(N, dtype=jnp.float32)[None, :]
    return {
        "x": nrm(ks[0], (BATCH, SEQ, D), 1.0),
        "c": nrm(ks[1], (BATCH, D), 1.0),
        "w_ada": nrm(ks[2], (L, D, N_SUBLAYERS * N_MOD * D), 0.5 * D ** -0.5),
        "b_ada": nrm(ks[3], (L, N_SUBLAYERS * N_MOD * D), 0.01),
        "g_ffn1": 1.0 + nrm(ks[4], (L, D), 0.01),
        "w_ffn1_in": nrm(ks[5], (L, D, 2 * F), D ** -0.5),
        "w_ffn1_out": nrm(ks[6], (L, F, D), F ** -0.5),
        "g_mix": 1.0 + nrm(ks[7], (L, D), 0.01),
        "w_in": nrm(ks[8], (L, D, IN_WIDTH), D ** -0.5),
        "pool_w": nrm(ks[9], (L, N_POOL_GROUPS, POOL_GROUP, POOL_GROUP), POOL_GROUP ** -0.5),
        "pool_b": nrm(ks[10], (L, POOL_WIDTH), 0.01),
        "pool_scale": 1.0 + nrm(ks[11], (L, POOL_WIDTH), 0.05),
        "w_pool_up": nrm(ks[12], (L, POOL_WIDTH, D), POOL_WIDTH ** -0.5),
        "ssm_lam_re_log": jnp.log(0.5) + nrm(ks[13], (L, G, N), 0.01),
        "ssm_lam_im": math.pi * n_idx + nrm(ks[14], (L, G, N), 0.01),
        "ssm_log_dt": jax.random.uniform(ks[15], (L, G), jnp.float32, math.log(DT_MIN), math.log(DT_MAX)),
        "ssm_b_re": nrm(ks[16], (L, G, N, H), (2 * H) ** -0.5),
        "ssm_b_im": nrm(ks[17], (L, G, N, H), (2 * H) ** -0.5),
        "ssm_c_re": nrm(ks[18], (L, G, H, N), N ** -0.5),
        "ssm_c_im": nrm(ks[19], (L, G, H, N), N ** -0.5),
        "ssm_d": nrm(ks[20], (L, SSM_WIDTH), 1.0),
        "w_glu": nrm(ks[21], (L, SSM_WIDTH, 2 * SSM_WIDTH), SSM_WIDTH ** -0.5),
        "b_glu": nrm(ks[22], (L, 2 * SSM_WIDTH), 0.01),
        "w_ssm_up": nrm(ks[23], (L, SSM_WIDTH, D), SSM_WIDTH ** -0.5),
        "w_out": nrm(ks[24], (L, D, D), D ** -0.5),
        "g_ffn2": 1.0 + nrm(ks[25], (L, D), 0.01),
        "w_ffn2_in": nrm(ks[26], (L, D, 2 * F), D ** -0.5),
        "w_ffn2_out": nrm(ks[27], (L, F, D), F ** -0.5),
        "g_final": 1.0 + nrm(ks[28], (D,), 0.01),
    }


def reference(x, c, w_ada, b_ada, g_ffn1, w_ffn1_in, w_ffn1_out, g_mix, w_in,
              pool_w, pool_b, pool_scale, w_pool_up,
              ssm_lam_re_log, ssm_lam_im, ssm_log_dt, ssm_b_re, ssm_b_im, ssm_c_re, ssm_c_im, ssm_d,
              w_glu, b_glu, w_ssm_up, w_out, g_ffn2, w_ffn2_in, w_ffn2_out, g_final):
    B = x.shape[0]
    split_pts = (POOL_WIDTH, POOL_WIDTH + SSM_WIDTH, POOL_WIDTH + SSM_WIDTH + D_MODEL)
    for l in range(DEPTH):
        mod = (jax.nn.silu(c) @ w_ada[l] + b_ada[l]).reshape(B, N_SUBLAYERS, N_MOD, D_MODEL)

        h = modulate(rms_norm(x, g_ffn1[l]), mod[:, 0, 0], mod[:, 0, 1])
        x = x + 0.5 * mod[:, 0, 2][:, None, :] * swiglu(h, w_ffn1_in[l], w_ffn1_out[l])

        h = modulate(rms_norm(x, g_mix[l]), mod[:, 1, 0], mod[:, 1, 1])
        u_pool, u_ssm, gl_pool, gl_ssm = jnp.split(h @ w_in[l], split_pts, axis=-1)
        y_pool = multiscale_pool(u_pool, pool_w[l], pool_b[l], pool_scale[l]) @ w_pool_up[l]
        y_ssm = s5_mixer(u_ssm, ssm_lam_re_log[l], ssm_lam_im[l], ssm_log_dt[l],
                         ssm_b_re[l], ssm_b_im[l], ssm_c_re[l], ssm_c_im[l], ssm_d[l],
                         w_glu[l], b_glu[l]) @ w_ssm_up[l]
        merged = jax.nn.sigmoid(gl_pool) * y_pool + jax.nn.sigmoid(gl_ssm) * y_ssm
        x = x + mod[:, 1, 2][:, None, :] * (merged @ w_out[l])

        h = modulate(rms_norm(x, g_ffn2[l]), mod[:, 2, 0], mod[:, 2, 1])
        x = x + 0.5 * mod[:, 2, 2][:, None, :] * swiglu(h, w_ffn2_in[l], w_ffn2_out[l])
    return rms_norm(x, g_final)
```

```cpp
#include <hip/hip_runtime.h>
#include <hip/hip_cooperative_groups.h>
#include <cstdio>
namespace cg = cooperative_groups;

#define LAS __attribute__((address_space(3)))
typedef unsigned short bf16_t;
typedef short bf16x8 __attribute__((ext_vector_type(8)));
typedef float f32x4 __attribute__((ext_vector_type(4)));
typedef unsigned u32x4 __attribute__((ext_vector_type(4)));
typedef unsigned u32x2 __attribute__((ext_vector_type(2)));

constexpr int D = 1024, BATCH = 8, SEQ = 4096, M = BATCH * SEQ, FF = 2816, NMODC = 9 * D;
constexpr int PWID = 512, SWID = 512, NG = 32, GH = 16, NS = 64;
constexpr int CL = 32, NCH = SEQ / CL, RPG = BATCH * NCH  , KA = 640  ;
constexpr float EPS = 1e-6f;
constexpr int MODKC = 16;

constexpr size_t MiB = 1u << 20;
constexpr size_t WS_PART = 0, WS_MOD = 5 * MiB, WS_A32 = 5 * MiB + 512 * 1024, WS_BAR = 5 * MiB + 768 * 1024, BAR_BYTES = 16384;
constexpr size_t WS_W1IN = 6 * MiB, WS_W1OUT = 17 * MiB, WS_WIN = 23 * MiB, WS_WPOOL = 29 * MiB, WS_WPUP = 30 * MiB, WS_WGLU = 31 * MiB,
                 WS_WSUP = 32 * MiB, WS_WOUT = 33 * MiB, WS_W2IN = 35 * MiB, WS_W2OUT = 46 * MiB, WS_BTE = 52 * MiB, WS_BTY = 60 * MiB;
constexpr size_t WS_H = 80 * MiB;
constexpr size_t WS_ACT = 144 * MiB;
constexpr size_t WS_UPOOL = 144 * MiB, WS_ASSM = 176 * MiB, WS_Z = 216 * MiB, WS_ZP = 248 * MiB, WS_E = 280 * MiB;
constexpr size_t WS_YG = WS_UPOOL, WS_SG = WS_Z;
constexpr size_t WS_SIGP = 320 * MiB, WS_SIGS = 384 * MiB, WS_RSS = 448 * MiB  , WS_SW = 450 * MiB  , WS_KT = 451 * MiB  , WS_END = 452 * MiB;

__device__ __forceinline__ unsigned cvt_pk_bf16(float lo, float hi) { unsigned r; asm volatile("v_cvt_pk_bf16_f32 %0, %1, %2" : "=v"(r) : "v"(lo), "v"(hi)); return r; }
__device__ __forceinline__ unsigned f2bf(float f) { unsigned u = __builtin_bit_cast(unsigned, f); return (u + 0x7fffu + ((u >> 16) & 1u)) >> 16; }
__device__ __forceinline__ float bflo(unsigned w) { return __builtin_bit_cast(float, w << 16); }
__device__ __forceinline__ float bfhi(unsigned w) { return __builtin_bit_cast(float, w & 0xffff0000u); }
__device__ __forceinline__ float sigm(float x) { return __builtin_amdgcn_rcpf(1.0f + __builtin_amdgcn_exp2f(x * -1.4426950408889634f)); }
typedef float f32x2 __attribute__((ext_vector_type(2)));
__device__ __forceinline__ f32x2 sigm2(f32x2 x) { const f32x2 t = x * -1.4426950408889634f; f32x2 e; e.x = __builtin_amdgcn_exp2f(t.x); e.y = __builtin_amdgcn_exp2f(t.y); const f32x2 d = e + 1.0f; f32x2 r; r.x = __builtin_amdgcn_rcpf(d.x); r.y = __builtin_amdgcn_rcpf(d.y); return r; }
__device__ __forceinline__ f32x4 sigm4(f32x4 x) { const f32x2 lo = sigm2((f32x2){x.x, x.y}), hi = sigm2((f32x2){x.z, x.w}); return (f32x4){lo.x, lo.y, hi.x, hi.y}; }
__device__ __forceinline__ f32x2 gelu_pk(f32x2 v) {
    const f32x2 av = __builtin_elementwise_abs(v), d = av * 0.2316418882f + 1.0f;
    f32x2 t; t.x = __builtin_amdgcn_rcpf(d.x); t.y = __builtin_amdgcn_rcpf(d.y);
    f32x2 q = t * 0.5307027145f + (-0.7265760135f); q = q * t + 0.7107068705f; q = q * t + (-0.142248368f); q = q * t + 0.127414796f; q = q * t;
    const f32x2 s = (v * v) * (-0.72134752044f);
    f32x2 e; e.x = __builtin_amdgcn_exp2f(s.x); e.y = __builtin_amdgcn_exp2f(s.y);
    const f32x2 m = v * (q * e), r = v - m;
    f32x2 o; o.x = v.x < 0.f ? m.x : r.x; o.y = v.y < 0.f ? m.y : r.y; return o;
}
__device__ __forceinline__ __amdgpu_buffer_rsrc_t wt_rsrc(const void* p, unsigned bytes) { return __builtin_amdgcn_make_buffer_rsrc((void*)p, 0, bytes, 0x00020000); }
template <int AUX> __device__ __forceinline__ void wt_store16(f32x4 v, __amdgpu_buffer_rsrc_t r, unsigned off) { __builtin_amdgcn_raw_buffer_store_b128(__builtin_bit_cast(u32x4, v), r, off, 0, AUX); }
template <int AUX> __device__ __forceinline__ void wt_store8(u32x2 v, __amdgpu_buffer_rsrc_t r, unsigned off) { __builtin_amdgcn_raw_buffer_store_b64(v, r, off, 0, AUX); }
__device__ __forceinline__ float wave_sum(float v) {
#pragma unroll
    for (int o = 1; o < 64; o <<= 1) v += __shfl_xor(v, o);
    return v;
}
#define LDS_WAIT() asm volatile("s_waitcnt lgkmcnt(0)" ::: "memory")

namespace pg8 {
constexpr int BM = 256, BK = 64, HALF = 128, HTB = HALF * BK * 2, STAGE_BYTES = 8 * HTB, NXCD = 8, WGM = 8;
__host__ __device__ __forceinline__ int lds_byte(int r, int c) { const int st = (r >> 4) * 2 + (c >> 5), rr = r & 15, cc = c & 31, ob = rr * 64 + cc * 2; return st * 1024 + (ob ^ (((ob >> 9) & 1) << 5)); }
__host__ __device__ __forceinline__ void stage_rc(int b, int& R, int& C) { const int st = b / 1024, sb = b % 1024, swz = sb ^ (((sb >> 9) & 1) << 5); R = (st >> 1) * 16 + swz / 64; C = (st & 1) * 32 + (swz % 64) / 2; }
__host__ __device__ __forceinline__ int perm32(int rho) { const int n = rho >> 4, i = rho & 15; return 8 * (i >> 2) + 4 * n + (i & 3); }

struct Unit { int pm, pn; };
struct Gemm { const bf16_t* A; const bf16_t* Bt; int lda, ldb, K; int kpn; };

struct StaticOrder {
    int nM, nN, nwg, G, c;
    __device__ void init(int Mr, int Nc, int G_, int c_) { nM = Mr / BM; nN = Nc / BM; nwg = nM * nN; G = G_; c = c_; }
    __device__ bool next(int i, Unit& u) const {
        const long L = (long)i * G + c; if (L >= nwg) return false;
        int wgid = (int)L; { const int q = nwg / NXCD, r = nwg % NXCD, xcd = wgid % NXCD, off = wgid / NXCD; wgid = (xcd < r ? xcd * (q + 1) : r * (q + 1) + (xcd - r) * q) + off; }
        const int nig = WGM * nN, gid = wgid / nig, fm = gid * WGM, gsz = (nM - fm) < WGM ? (nM - fm) : WGM;
        u.pm = fm + ((wgid % nig) % gsz); u.pn = (wgid % nig) / gsz; return true;
    }
};
struct OrderE {
    int G, c;
    __device__ bool next(int i, Unit& u) const { const int xcd = c & 7, slot = c >> 3; if (i > 0 || G != 256 || slot >= 16) return false; const int g = xcd * 4 + (slot >> 2); u.pm = g * 4 + (slot & 3); u.pn = g; return true; }
};
struct OrderY {
    int G, c;
    __device__ bool next(int i, Unit& u) const { const int xcd = c & 7, slot = c >> 3; if (i > 0 || G != 256) return false; const int g = xcd * 4 + (slot >> 3), rem = slot & 7; u.pm = g * 4 + (rem & 3); u.pn = g * 2 + (rem >> 2); return true; }
};

template <class Epi, class Sched, bool ALIGN_EPI>
__device__ __forceinline__ void gemm_phase(LAS unsigned char* lds, const Gemm g, const Sched& S, const Epi& E) {
    int tid_ = threadIdx.x; asm volatile("" : "+v"(tid_));
    const int tid = tid_, wid = __builtin_amdgcn_readfirstlane(tid >> 6), lane = tid & 63, wr = wid >> 2, wc = wid & 3, fr = lane & 15, fq = lane >> 4;
    const int K = g.K, nt = K / BK;
    unsigned voffA[2], voffB[2];
#pragma unroll
    for (int i = 0; i < 2; ++i) { int R, C; stage_rc(tid * 16 + i * 8192, R, C); const int Rb = Epi::PERM ? ((R & ~31) + perm32(R & 31)) : R;
        voffA[i] = (unsigned)(R * g.lda + C) * 2u; voffB[i] = (unsigned)(Rb * g.ldb + C) * 2u; }
    const size_t kstep = (size_t)(BK * 2);
    const size_t hstepA = (size_t)HALF * g.lda * 2, hstepB = (size_t)HALF * g.ldb * 2;
    const size_t tstepA = 2 * hstepA, tstepB = 2 * hstepB;
    const unsigned ldsw = (unsigned)wid * 1024u;
    const int aoff = lds_byte(wr * 64 + fr, fq * 8), boff = lds_byte(wc * 32 + fr, fq * 8);
#define PG8_SA(b, h) (((b) * 2 + (h)) * HTB)
#define PG8_SB(b, h) ((4 + (b) * 2 + (h)) * HTB)
#define PG8_STAGE(bufoff, gbase, voff) do { _Pragma("unroll") for (int _i = 0; _i < 2; ++_i) \
        __builtin_amdgcn_global_load_lds((const unsigned*)((const char*)(gbase) + (voff)[_i]), (LAS unsigned*)(lds + (bufoff) + ldsw + _i * 8192), 16, 0, 0); } while (0)
#define PG8_LDA(dst, b, h) do { _Pragma("unroll") for (int m = 0; m < 4; ++m) _Pragma("unroll") for (int k = 0; k < 2; ++k) dst[m][k] = *(const LAS bf16x8*)(lds + PG8_SA(b, h) + aoff + m * 2048 + k * 1024); } while (0)
#define PG8_LDB(dst, b, h) do { _Pragma("unroll") for (int n = 0; n < 2; ++n) _Pragma("unroll") for (int k = 0; k < 2; ++k) dst[n][k] = *(const LAS bf16x8*)(lds + PG8_SB(b, h) + boff + n * 2048 + k * 1024); } while (0)
#define PG8_MMA(ai, bj, At, Bt) do { __builtin_amdgcn_s_setprio(1); _Pragma("unroll") for (int m = 0; m < 4; ++m) _Pragma("unroll") for (int n = 0; n < 2; ++n) _Pragma("unroll") for (int k = 0; k < 2; ++k) \
        acc[ai][bj][m][n] = __builtin_amdgcn_mfma_f32_16x16x32_bf16(Bt[n][k], At[m][k], acc[ai][bj][m][n], 0, 0, 0); __builtin_amdgcn_s_setprio(0); } while (0)
#define PG8_WAIT_V(n) asm volatile("s_waitcnt vmcnt(" #n ")" ::: "memory")
#define PG8_WAIT_L(n) asm volatile("s_waitcnt lgkmcnt(" #n ")" ::: "memory")
#define PG8_BAR __builtin_amdgcn_s_barrier()
#define PG8_SCHED __builtin_amdgcn_sched_barrier(0)
    Unit cur, nxt; int ui = 0;
    if (!S.next(0, cur)) return;
    f32x4 acc[2][2][4][2];
#pragma unroll
    for (int a = 0; a < 2; ++a)
#pragma unroll
        for (int b = 0; b < 2; ++b)
#pragma unroll
            for (int m = 0; m < 4; ++m)
#pragma unroll
                for (int n = 0; n < 2; ++n) acc[a][b][m][n] = (f32x4){0.f, 0.f, 0.f, 0.f};
    bf16x8 At[4][2], B0[2][2], B1[2][2];
    const char* cA = (const char*)g.A + (size_t)cur.pm * tstepA + (size_t)cur.pn * g.kpn; const char* cB = (const char*)g.Bt + (size_t)cur.pn * tstepB + (size_t)cur.pn * g.kpn;
    PG8_STAGE(PG8_SB(0, 0), cB, voffB); PG8_STAGE(PG8_SB(0, 1), cB + hstepB, voffB); PG8_STAGE(PG8_SA(0, 0), cA, voffA); PG8_STAGE(PG8_SA(0, 1), cA + hstepA, voffA);
    if (wr == 1) PG8_BAR;
    PG8_WAIT_V(2); PG8_BAR;
    PG8_STAGE(PG8_SB(1, 0), cB + kstep, voffB); PG8_STAGE(PG8_SA(1, 0), cA + kstep, voffA); PG8_STAGE(PG8_SB(1, 1), cB + hstepB + kstep, voffB);
    PG8_WAIT_V(6); PG8_BAR;
    for (;;) {
        const bool has_next = S.next(ui + 1, nxt);
        const char* nA = has_next ? (const char*)g.A + (size_t)nxt.pm * tstepA + (size_t)nxt.pn * g.kpn : cA; const char* nB = has_next ? (const char*)g.Bt + (size_t)nxt.pn * tstepB + (size_t)nxt.pn * g.kpn : cB;
#pragma nounroll
        for (int t = 0; t < nt; t += 2) {
            const bool last = (t == nt - 2);
            const char* a1 = cA + (size_t)(t + 1) * kstep;
            const char* a2 = last ? nA : cA + (size_t)(t + 2) * kstep; const char* b2 = last ? nB : cB + (size_t)(t + 2) * kstep;
            const char* a3 = a2 + kstep; const char* b3 = b2 + kstep;
            PG8_LDB(B0, 0, 0); PG8_LDB(B1, 0, 1); PG8_SCHED; PG8_LDA(At, 0, 0); PG8_STAGE(PG8_SA(1, 1), a1 + hstepA, voffA);
            PG8_WAIT_V(8); PG8_WAIT_L(0); PG8_BAR; PG8_MMA(0, 0, At, B0); PG8_MMA(0, 1, At, B1); PG8_BAR; PG8_SCHED;
            PG8_LDA(At, 0, 1); PG8_STAGE(PG8_SB(0, 0), b2, voffB); PG8_STAGE(PG8_SB(0, 1), b2 + hstepB, voffB); PG8_STAGE(PG8_SA(0, 0), a2, voffA);
            PG8_WAIT_V(8); PG8_WAIT_L(0); PG8_BAR; PG8_MMA(1, 0, At, B0); PG8_MMA(1, 1, At, B1); PG8_BAR; PG8_SCHED;
            PG8_LDB(B0, 1, 0); PG8_LDB(B1, 1, 1); PG8_SCHED; PG8_LDA(At, 1, 0); PG8_STAGE(PG8_SA(0, 1), a2 + hstepA, voffA);
            PG8_WAIT_V(8); PG8_WAIT_L(0); PG8_BAR; PG8_MMA(0, 0, At, B0); PG8_MMA(0, 1, At, B1); PG8_BAR; PG8_SCHED;
            PG8_LDA(At, 1, 1); PG8_STAGE(PG8_SB(1, 0), b3, voffB); PG8_STAGE(PG8_SB(1, 1), b3 + hstepB, voffB); PG8_STAGE(PG8_SA(1, 0), a3, voffA);
            PG8_WAIT_V(8); PG8_WAIT_L(0); PG8_BAR; PG8_MMA(1, 0, At, B0); PG8_MMA(1, 1, At, B1); PG8_BAR; PG8_SCHED;
        }
        if constexpr (ALIGN_EPI) { if (wr == 0) PG8_BAR; }
        E(acc, cur, ui, wr, wc, fr, fq);
        if (!has_next) break;
#pragma unroll
        for (int a = 0; a < 2; ++a)
#pragma unroll
            for (int b = 0; b < 2; ++b)
#pragma unroll
                for (int m = 0; m < 4; ++m)
#pragma unroll
                    for (int n = 0; n < 2; ++n) acc[a][b][m][n] = (f32x4){0.f, 0.f, 0.f, 0.f};
        cur = nxt; cA = nA; cB = nB; ++ui;
        if constexpr (ALIGN_EPI) { if (wr == 1) PG8_BAR; }
    }
    PG8_WAIT_V(0);
    if constexpr (!ALIGN_EPI) { if (wr == 0) PG8_BAR; }
    PG8_BAR;
#undef PG8_SA
#undef PG8_SB
#undef PG8_STAGE
#undef PG8_LDA
#undef PG8_LDB
#undef PG8_MMA
#undef PG8_WAIT_V
#undef PG8_WAIT_L
#undef PG8_BAR
#undef PG8_SCHED
}

typedef f32x4 Acc[2][2][4][2];

__device__ __forceinline__ u32x4 pack8(const f32x4 v0, const f32x4 v1) { u32x4 w; w.x = cvt_pk_bf16(v0[0], v0[1]); w.y = cvt_pk_bf16(v0[2], v0[3]); w.z = cvt_pk_bf16(v1[0], v1[1]); w.w = cvt_pk_bf16(v1[2], v1[3]); return w; }
__device__ __forceinline__ void unpack8(const u32x4 w, f32x4& v0, f32x4& v1) { v0 = (f32x4){bflo(w.x), bfhi(w.x), bflo(w.y), bfhi(w.y)}; v1 = (f32x4){bflo(w.z), bfhi(w.z), bflo(w.w), bfhi(w.w)}; }

template <bool NORM> struct EpiSwiGLU {
    static constexpr bool PERM = true;
    bf16_t* O; int ldo; const LAS float* rstdL; const LAS float* swL;
    __device__ __forceinline__ void operator()(const Acc& acc, const Unit& u, int ui, int wr, int wc, int fr, int fq) const {
        const int col0 = u.pn * HALF + wc * 32 + 8 * fq;
        f32x4 sa[2], sb[2];
        if (NORM) { const LAS float* sp = swL + ui * 256 + wc * 32 + 8 * fq;
#pragma unroll
            for (int n = 0; n < 2; ++n) { sa[n] = *(const LAS f32x4*)(sp + 4 * n); sb[n] = *(const LAS f32x4*)(sp + HALF + 4 * n); } }
#pragma unroll
        for (int ai = 0; ai < 2; ++ai)
#pragma unroll
            for (int m = 0; m < 4; ++m) {
                const int rl = wr * 64 + fr + ai * HALF + m * 16, r = u.pm * BM + rl;
                float rstd = 1.0f;
                if (NORM) rstd = rstdL[ui * 256 + rl];
                f32x4 v[2];
#pragma unroll
                for (int n = 0; n < 2; ++n) { f32x4 a = acc[ai][0][m][n], b = acc[ai][1][m][n];
                    if (NORM) { a = a * rstd + sa[n]; b = b * rstd + sb[n]; }
                    v[n] = (a * b) * sigm4(a); }
                *(u32x4*)(O + (size_t)r * ldo + col0) = pack8(v[0], v[1]);
            }
    }
};
struct EpiGLU {
    static constexpr bool PERM = true;
    bf16_t* O; int ldo; const float* bias; int nhalf;
    __device__ __forceinline__ void operator()(const Acc& acc, const Unit& u, int ui, int wr, int wc, int fr, int fq) const {
        const int row0 = u.pm * BM + wr * 64 + fr, col0 = u.pn * HALF + wc * 32 + 8 * fq;
        f32x4 bv[2], bg[2];
#pragma unroll
        for (int n = 0; n < 2; ++n) { bv[n] = *(const f32x4*)(bias + col0 + 4 * n); bg[n] = *(const f32x4*)(bias + nhalf + col0 + 4 * n); }
#pragma unroll
        for (int ai = 0; ai < 2; ++ai)
#pragma unroll
            for (int m = 0; m < 4; ++m) {
                f32x4 v[2];
#pragma unroll
                for (int n = 0; n < 2; ++n) { const f32x4 a = acc[ai][0][m][n] + bv[n], b = acc[ai][1][m][n] + bg[n];
                    v[n] = a * sigm4(b); }
                *(u32x4*)(O + (size_t)(row0 + ai * HALF + m * 16) * ldo + col0) = pack8(v[0], v[1]);
            }
    }
};
template <bool NEXT, bool HALFS> struct EpiResid {
    static constexpr bool PERM = false;
    static constexpr float s = HALFS ? 0.5f : 1.0f;
    const float* base; float* out; const float* gate0;
    bf16_t* xg; const float* gnext; const float* scale0; float* rss;
    __device__ __forceinline__ void operator()(const Acc& acc, const Unit& u, int ui, int wr, int wc, int fr, int fq) const {
        const int row0 = u.pm * BM + wr * 64 + fr, col0 = u.pn * BM + wc * 32 + 4 * fq;
        const float* gate = gate0 + (size_t)(u.pm >> 4) * NMODC;
        const char* bp = (const char*)base; char* op = (char*)out; char* xp = (char*)xg;
        unsigned rb[2][4];
        float ss[2][4];
#pragma unroll
        for (int ai = 0; ai < 2; ++ai)
#pragma unroll
            for (int m = 0; m < 4; ++m) { ss[ai][m] = 0.f; rb[ai][m] = (unsigned)((row0 + ai * HALF + m * 16) * D + col0) * 4u; }
#pragma unroll
        for (int bj = 0; bj < 2; ++bj)
#pragma unroll
            for (int n = 0; n < 2; ++n) {
                const int c = col0 + bj * HALF + n * 16; const unsigned cb = (unsigned)(bj * HALF + n * 16) * 4u;
                f32x4 bs[2][4];
#pragma unroll
                for (int ai = 0; ai < 2; ++ai)
#pragma unroll
                    for (int m = 0; m < 4; ++m) bs[ai][m] = *(const f32x4*)(bp + (rb[ai][m] + cb));
                const f32x4 gv = *(const f32x4*)(gate + c) * s;
                f32x4 gsv = gv;
                if (NEXT) gsv = *(const f32x4*)(gnext + c) * (*(const f32x4*)(scale0 + (size_t)(u.pm >> 4) * NMODC + c) + 1.0f);
#pragma unroll
                for (int ai = 0; ai < 2; ++ai)
#pragma unroll
                    for (int m = 0; m < 4; ++m) {
                        const f32x4 xn = bs[ai][m] + gv * acc[ai][bj][m][n];
                        *(f32x4*)(op + (rb[ai][m] + cb)) = xn;
                        if (NEXT) { ss[ai][m] += (xn.x * xn.x + xn.y * xn.y) + (xn.z * xn.z + xn.w * xn.w); const f32x4 o = xn * gsv; u32x2 w; w.x = cvt_pk_bf16(o.x, o.y); w.y = cvt_pk_bf16(o.z, o.w);
                            *(u32x2*)(xp + ((rb[ai][m] + cb) >> 1)) = w; } }
            }
        if (NEXT) {
#pragma unroll
            for (int ai = 0; ai < 2; ++ai)
#pragma unroll
                for (int m = 0; m < 4; ++m) { float t = ss[ai][m]; t += __shfl_xor(t, 16); t += __shfl_xor(t, 32); if (fq == 0) rss[(size_t)(row0 + ai * HALF + m * 16) * 16 + u.pn * 4 + wc] = t; }
        }
    }
};
struct EpiWin {
    static constexpr bool PERM = true;
    bf16_t *upool, *assm, *sigp, *sigs; const LAS float* rstdL; const LAS float* swL;
    __device__ __forceinline__ void operator()(const Acc& acc, const Unit& u, int ui, int wr, int wc, int fr, int fq) const {
        const int pn = u.pn;
        f32x4 sv[2][2];
        { const LAS float* sp = swL + ui * 256 + wc * 32 + 8 * fq;
#pragma unroll
          for (int bj = 0; bj < 2; ++bj)
#pragma unroll
              for (int n = 0; n < 2; ++n) sv[bj][n] = *(const LAS f32x4*)(sp + bj * HALF + 4 * n); }
#pragma unroll
        for (int ai = 0; ai < 2; ++ai)
#pragma unroll
            for (int m = 0; m < 4; ++m) { const int rl = wr * 64 + fr + ai * HALF + m * 16, r = u.pm * BM + rl;
                const float rstd = rstdL[ui * 256 + rl];
#pragma unroll
                for (int bj = 0; bj < 2; ++bj) {
                    f32x4 v0 = acc[ai][bj][m][0] * rstd + sv[bj][0], v1 = acc[ai][bj][m][1] * rstd + sv[bj][1];
                    const int cl = bj * HALF + wc * 32 + 8 * fq;
                    if (pn < 2) { *(u32x4*)(upool + (size_t)r * PWID + pn * BM + cl) = pack8(v0, v1); }
                    else if (pn < 4) { const int cs = (pn - 2) * BM + cl, g = cs >> 4, h0 = cs & 15;
                        *(u32x4*)(assm + ((size_t)(g * RPG + (r >> 5)) * KA + (r & 31) * GH + h0)) = pack8(v0, v1); }
                    else {
                        v0 = sigm4(v0); v1 = sigm4(v1);
                        bf16_t* dst = (pn < 8) ? (sigp + (size_t)r * D + (pn - 4) * BM + cl) : (sigs + (size_t)r * D + (pn - 8) * BM + cl);
                        *(u32x4*)dst = pack8(v0, v1); }
                } }
    }
};
struct EpiPool1 {
    static constexpr bool PERM = true;
    bf16_t* O; const float* pb; const float* ps;
    __device__ __forceinline__ void operator()(const Acc& acc, const Unit& u, int ui, int wr, int wc, int fr, int fq) const {
        const int row0 = u.pm * BM + wr * 64 + fr, col0 = u.pn * BM + wc * 32 + 8 * fq;
        f32x4 b[2][2], s[2][2];
#pragma unroll
        for (int bj = 0; bj < 2; ++bj)
#pragma unroll
            for (int n = 0; n < 2; ++n) { b[bj][n] = *(const f32x4*)(pb + col0 + bj * HALF + 4 * n); s[bj][n] = *(const f32x4*)(ps + col0 + bj * HALF + 4 * n); }
#pragma unroll
        for (int ai = 0; ai < 2; ++ai)
#pragma unroll
            for (int m = 0; m < 4; ++m) { bf16_t* rowp = O + (size_t)(row0 + ai * HALF + m * 16) * PWID + col0;
#pragma unroll
                for (int bj = 0; bj < 2; ++bj) *(u32x4*)(rowp + bj * HALF) = pack8((acc[ai][bj][m][0] + b[bj][0]) * s[bj][0], (acc[ai][bj][m][1] + b[bj][1]) * s[bj][1]); }
    }
};
template <bool ADD> struct EpiGateAcc {
    static constexpr bool PERM = true;
    bf16_t* O; const bf16_t* sig;
    __device__ __forceinline__ void operator()(const Acc& acc, const Unit& u, int ui, int wr, int wc, int fr, int fq) const {
        const int row0 = u.pm * BM + wr * 64 + fr, col0 = u.pn * BM + wc * 32 + 8 * fq;
#pragma unroll
        for (int ai = 0; ai < 2; ++ai) {
            u32x4 sg[4][2], pv[4][2];
#pragma unroll
            for (int m = 0; m < 4; ++m)
#pragma unroll
                for (int bj = 0; bj < 2; ++bj) { const size_t off = (size_t)(row0 + ai * HALF + m * 16) * D + col0 + bj * HALF; sg[m][bj] = *(const u32x4*)(sig + off); if (ADD) pv[m][bj] = *(const u32x4*)(O + off); }
#pragma unroll
            for (int m = 0; m < 4; ++m) { const size_t off = (size_t)(row0 + ai * HALF + m * 16) * D + col0;
#pragma unroll
                for (int bj = 0; bj < 2; ++bj) { f32x4 s0, s1; unpack8(sg[m][bj], s0, s1);
                    f32x4 v0 = s0 * acc[ai][bj][m][0], v1 = s1 * acc[ai][bj][m][1];
                    if (ADD) { f32x4 p0, p1; unpack8(pv[m][bj], p0, p1); v0 += p0; v1 += p1; }
                    *(u32x4*)(O + off + bj * HALF) = pack8(v0, v1); } }
        }
    }
};
struct EpiPlain {
    static constexpr bool PERM = true;
    bf16_t* O; int ldo;
    __device__ __forceinline__ void operator()(const Acc& acc, const Unit& u, int ui, int wr, int wc, int fr, int fq) const {
        const int row0 = u.pm * BM + wr * 64 + fr, col0 = u.pn * BM + wc * 32 + 8 * fq;
#pragma unroll
        for (int ai = 0; ai < 2; ++ai)
#pragma unroll
            for (int m = 0; m < 4; ++m) { bf16_t* rowp = O + (size_t)(row0 + ai * HALF + m * 16) * ldo + col0;
#pragma unroll
                for (int bj = 0; bj < 2; ++bj) *(u32x4*)(rowp + bj * HALF) = pack8(acc[ai][bj][m][0], acc[ai][bj][m][1]); }
    }
};
struct EpiE {
    static constexpr bool PERM = false;
    float* E;
    __device__ __forceinline__ void operator()(const Acc& acc, const Unit& u, int ui, int wr, int wc, int fr, int fq) const {
        const int row0 = u.pm * BM + wr * 64 + fr, col0 = wc * 32 + 4 * fq;
#pragma unroll
        for (int ai = 0; ai < 2; ++ai)
#pragma unroll
            for (int m = 0; m < 4; ++m) { float* rowp = E + (size_t)(row0 + ai * HALF + m * 16) * 128 + col0;
#pragma unroll
                for (int n = 0; n < 2; ++n) *(f32x4*)(rowp + n * 16) = acc[ai][0][m][n]; }
    }
};
struct EpiY {
    static constexpr bool PERM = true;
    bf16_t* yg; const bf16_t* assm; const float* dskip;
    __device__ __forceinline__ void operator()(const Acc& acc, const Unit& u, int ui, int wr, int wc, int fr, int fq) const {
        const int g = u.pm >> 2, pnl = u.pn & 1;
        const int arow0 = u.pm * BM + wr * 64 + fr;
#pragma unroll
        for (int bj = 0; bj < 2; ++bj) {
            const int nloc = pnl * BM + bj * HALF + wc * 32 + 8 * fq, tl = nloc >> 4, h0 = nloc & 15;
            const f32x4 d0 = *(const f32x4*)(dskip + g * GH + h0), d1 = *(const f32x4*)(dskip + g * GH + h0 + 4);
            u32x4 uu[2][4];
#pragma unroll
            for (int ai = 0; ai < 2; ++ai)
#pragma unroll
                for (int m = 0; m < 4; ++m) uu[ai][m] = *(const u32x4*)(assm + (size_t)(arow0 + ai * HALF + m * 16) * KA + nloc);
#pragma unroll
            for (int ai = 0; ai < 2; ++ai)
#pragma unroll
                for (int m = 0; m < 4; ++m) { const int arow = arow0 + ai * HALF + m * 16, rl = arow - g * RPG;
                    f32x4 u0, u1; unpack8(uu[ai][m], u0, u1);
                    f32x4 v0 = acc[ai][bj][m][0] + d0 * u0, v1 = acc[ai][bj][m][1] + d1 * u1;
                    { const f32x2 g0 = gelu_pk((f32x2){v0[0], v0[1]}), g1 = gelu_pk((f32x2){v0[2], v0[3]}), g2 = gelu_pk((f32x2){v1[0], v1[1]}), g3 = gelu_pk((f32x2){v1[2], v1[3]});
                      v0 = (f32x4){g0.x, g0.y, g1.x, g1.y}; v1 = (f32x4){g2.x, g2.y, g3.x, g3.y}; }
                    *(u32x4*)(yg + (size_t)(rl * CL + tl) * SWID + g * GH + h0) = pack8(v0, v1); }
        }
    }
};
}

#define XB_TMO      128
#define XB_XCNT(j)  (256  + 64 * (j))
#define XB_XSUB(j)  (1280 + 64 * (j))
#define XB_XGEN(j)  (2304 + 64 * (j))
#define XB_TOP      3328
#define XB_TOPGEN   3392
#define XCD_BAR_WORDS 3456
#define XB_SPIN_CAP (1u << 22)
__device__ __forceinline__ unsigned xb_ld(unsigned* p)              { return __hip_atomic_load(p, __ATOMIC_RELAXED, __HIP_MEMORY_SCOPE_AGENT); }
__device__ __forceinline__ unsigned xb_add(unsigned* p, unsigned v) { return __hip_atomic_fetch_add(p, v, __ATOMIC_RELAXED, __HIP_MEMORY_SCOPE_AGENT); }
__device__ __forceinline__ unsigned xb_xcc_id() { return (unsigned)__builtin_amdgcn_s_getreg((3 << 11) | 20) & 0xFu; }
#define XB_SPIN(cond, bar) do { unsigned _sp = 0; while (cond) { __builtin_amdgcn_s_sleep(1); \
    if ((++_sp & 255u) == 0u) { if (xb_ld(&(bar)[XB_TMO])) break; if (_sp > XB_SPIN_CAP) { atomicAdd(&(bar)[XB_TMO], 1u); break; } } } } while (0)
struct XcdBarrier { unsigned* bar; unsigned x; volatile LAS unsigned* st; };
__device__ __forceinline__ XcdBarrier xcd_barrier_post(unsigned* bar, volatile LAS unsigned* st) {
    XcdBarrier b; b.bar = bar; b.x = xb_xcc_id(); b.st = st;
    if (threadIdx.x == 0) (void)xb_add(&bar[XB_XCNT(b.x)], 1u);
    return b;
}
__device__ __forceinline__ void xcd_barrier_complete(unsigned* bar, unsigned x, unsigned& nloc, unsigned& nx) {
    const unsigned G = gridDim.x * gridDim.y * gridDim.z;
    unsigned sum, cnt, mine, sp = 0u;
    for (;;) {
        sum = 0u; cnt = 0u; mine = 0u;
#pragma unroll
        for (unsigned j = 0; j < 16; ++j) { const unsigned c = xb_ld(&bar[XB_XCNT(j)]); sum += c; cnt += (c > 0u) ? 1u : 0u; mine = (j == x) ? c : mine; }
        if (sum == G) break;
        __builtin_amdgcn_s_sleep(1);
        if ((++sp & 255u) == 0u) { if (xb_ld(&bar[XB_TMO])) break; if (sp > XB_SPIN_CAP) { atomicAdd(&bar[XB_TMO], 1u); break; } }
    }
    nloc = mine > 0u ? mine : 1u; nx = cnt > 0u ? cnt : 1u;
}
__device__ __forceinline__ void xcd_barrier(const XcdBarrier& b) {
    asm volatile("s_waitcnt vmcnt(0)" ::: "memory");
    __syncthreads();
    if (threadIdx.x == 0) {
        unsigned* bar = b.bar;
        __builtin_amdgcn_s_waitcnt(0);
        unsigned nloc = b.st[0], nx = b.st[1];
        if (nloc == 0u) { xcd_barrier_complete(bar, b.x, nloc, nx); b.st[0] = nloc; b.st[1] = nx; }
        const unsigned old = xb_add(&bar[XB_XSUB(b.x)], 1u);
        const unsigned gen = old / nloc;
        if (old + 1u == (gen + 1u) * nloc) {
            __builtin_amdgcn_fence(__ATOMIC_RELEASE, "agent");
            asm volatile("s_waitcnt vmcnt(0)" ::: "memory");
            const unsigned og = xb_add(&bar[XB_TOP], 1u);
            const unsigned tg = og / nx;
            if (og + 1u == (tg + 1u) * nx) xb_add(&bar[XB_TOPGEN], 1u);
            else XB_SPIN(xb_ld(&bar[XB_TOPGEN]) == tg, bar);
            __builtin_amdgcn_fence(__ATOMIC_ACQUIRE, "agent");
            xb_add(&bar[XB_XGEN(b.x)], 1u);
            asm volatile("s_waitcnt vmcnt(0)" ::: "memory");
        } else {
            XB_SPIN(xb_ld(&bar[XB_XGEN(b.x)]) == gen, bar);
            __builtin_amdgcn_fence(__ATOMIC_ACQUIRE, "agent");
            asm volatile("s_waitcnt vmcnt(0)" ::: "memory");
        }
    }
    __syncthreads();
}

struct Args { const float* in[29]; float* out; unsigned char* ws; };

__device__ __forceinline__ void transpose_block(const float* __restrict__ W, int N, bf16_t* WT, int ldo, int k0, int n0, int orow0, LAS float* scr, int lane) {
    float t[32];
    const float* Wk = W + (size_t)k0 * N + n0;
    const unsigned lo = (unsigned)((lane >> 5) * N + (lane & 31));
#pragma unroll
    for (int i = 0; i < 32; ++i) t[i] = __builtin_nontemporal_load((Wk + (size_t)(2 * i) * N) + lo);
#pragma unroll
    for (int i = 0; i < 32; ++i) { const int kk = 2 * i + (lane >> 5); scr[kk * 33 + (lane & 31)] = t[i]; }
    LDS_WAIT();
    const int c = lane & 7;
#pragma unroll
    for (int j = 0; j < 4; ++j) { const int n = (lane >> 3) + 8 * j; const LAS float* s = scr + (8 * c) * 33 + n;
        u32x4 o; o.x = cvt_pk_bf16(s[0 * 33], s[1 * 33]); o.y = cvt_pk_bf16(s[2 * 33], s[3 * 33]); o.z = cvt_pk_bf16(s[4 * 33], s[5 * 33]); o.w = cvt_pk_bf16(s[6 * 33], s[7 * 33]);
        *(u32x4*)(WT + (size_t)(orow0 + n) * ldo + k0 + 8 * c) = o; }
    LDS_WAIT();
}
__device__ __forceinline__ void transpose_item(const float* W, int K, int N, bf16_t* WT, int nhalf, int item, LAS float* scr, int lane) {
    const int nblk = N / 32, kb = item / nblk, nb = item % nblk, k0 = 64 * kb, n0 = 32 * nb;
    int orow0 = n0;
    if (nhalf > 0) { const int h = n0 / nhalf, j = n0 % nhalf; orow0 = 256 * (j / 128) + 128 * h + (j % 128); }
    transpose_block(W, N, WT, K, k0, n0, orow0, scr, lane);
}

__device__ __forceinline__ void ssm_prep_stage1(const Args& a, int g, int sub, LAS float* L, int tid) {
    LAS float* PWR = L; LAS float* PWI = L + 2112; LAS float* BBR = L + 4224; LAS float* BBI = L + 5248; LAS float* CR = L + 6272; LAS float* CI = L + 7296;
    const float* lam_re_log = a.in[13]; const float* lam_im = a.in[14]; const float* log_dt = a.in[15];
    const float* b_re = a.in[16]; const float* b_im = a.in[17]; const float* c_re = a.in[18]; const float* c_im = a.in[19];
    bf16_t* BtY = (bf16_t*)(a.ws + WS_BTY); bf16_t* BtE = (bf16_t*)(a.ws + WS_BTE); float* A32 = (float*)(a.ws + WS_A32); float* KTg = (float*)(a.ws + WS_KT);
    if (tid < 64) {
        const int n = tid;
        const float lr = -expf(lam_re_log[g * NS + n]), li = lam_im[g * NS + n], dt = expf(log_dt[g]);
        const float mag = expf(lr * dt), ang = li * dt;
        const float abr = mag * cosf(ang), abi = mag * sinf(ang);
        const float nr = abr - 1.0f, ni = abi, den = lr * lr + li * li;
        const float fr = (nr * lr + ni * li) / den, fi = (ni * lr - nr * li) / den;
        float pr = 1.0f, pi = 0.0f;
        for (int tau = 0; tau <= CL; ++tau) { PWR[tau * NS + n] = pr; PWI[tau * NS + n] = pi; const float q = pr * abr - pi * abi; pi = pr * abi + pi * abr; pr = q; }
        if (sub == 0) { A32[(g * NS + n) * 2] = PWR[CL * NS + n]; A32[(g * NS + n) * 2 + 1] = PWI[CL * NS + n]; }
        for (int hp = 0; hp < GH; ++hp) { const float br = b_re[(g * NS + n) * GH + hp], bi = b_im[(g * NS + n) * GH + hp];
            BBR[n * GH + hp] = fr * br - fi * bi; BBI[n * GH + hp] = fr * bi + fi * br; }
    }
    for (int e = tid; e < GH * NS; e += 512) { CR[e] = c_re[g * GH * NS + e]; CI[e] = c_im[g * GH * NS + e]; }
    __syncthreads();
    for (int e = tid; e < 4 * GH * GH; e += 512) { const int tau = 4 * sub + (e >> 8), h = (e >> 4) & 15, hp = e & 15; float s = 0.f;
        for (int n = 0; n < NS; ++n) { const float pr = PWR[tau * NS + n], pi = PWI[tau * NS + n], br = BBR[n * GH + hp], bi = BBI[n * GH + hp];
            const float Pr = pr * br - pi * bi, Pi = pr * bi + pi * br; s += CR[h * NS + n] * Pr - CI[h * NS + n] * Pi; }
        KTg[(size_t)g * (CL * 256) + tau * 256 + (e & 255)] = s; }
    for (int q = tid; q < 64 * 16; q += 512) { const int row = 64 * sub + (q >> 4), ch = q & 15, t = row >> 4, h = row & 15, isim = ch >> 3, n0 = (ch & 7) * 8;
        float v[8];
#pragma unroll
        for (int j = 0; j < 8; ++j) { const int n = n0 + j; const float cr = CR[h * NS + n], ci = CI[h * NS + n], pr = PWR[(t + 1) * NS + n], pi = PWI[(t + 1) * NS + n];
            v[j] = isim ? -(cr * pi + ci * pr) : (cr * pr - ci * pi); }
        u32x4 o; o.x = cvt_pk_bf16(v[0], v[1]); o.y = cvt_pk_bf16(v[2], v[3]); o.z = cvt_pk_bf16(v[4], v[5]); o.w = cvt_pk_bf16(v[6], v[7]);
        *(u32x4*)(BtY + ((size_t)(g * 512 + row) * KA + 512 + isim * 64 + n0)) = o; }
    for (int q = tid; q < 32 * 64; q += 512) { const int row = 32 * sub + (q >> 6), ch = q & 63, s = ch >> 1, hp0 = (ch & 1) * 8;
        u32x4 o = (u32x4){0u, 0u, 0u, 0u};
        if (row < 128) { const int n = row & 63, isim = row >> 6; const float pr = PWR[(CL - 1 - s) * NS + n], pi = PWI[(CL - 1 - s) * NS + n];
            float v[8];
#pragma unroll
            for (int j = 0; j < 8; ++j) { const float br = BBR[n * GH + hp0 + j], bi = BBI[n * GH + hp0 + j]; v[j] = isim ? (pr * bi + pi * br) : (pr * br - pi * bi); }
            o.x = cvt_pk_bf16(v[0], v[1]); o.y = cvt_pk_bf16(v[2], v[3]); o.z = cvt_pk_bf16(v[4], v[5]); o.w = cvt_pk_bf16(v[6], v[7]); }
        *(u32x4*)(BtE + ((size_t)(g * 256 + row) * 512 + s * GH + hp0)) = o; }
    __syncthreads();
}

template <bool HASD, bool WRX, bool FINAL, bool XOUTB = false>
__device__ __forceinline__ void row_pass(const float* Xin, const bf16_t* delta, const float* gate0, float s, float* Xout, const float* gvec, const float* mod, int sub, bf16_t* Hout, int gw, int ngw, int lane) {
    for (int blk = gw; blk < M / 16; blk += ngw) {
        const int r0 = blk * 16, b = r0 / SEQ;
        f32x4 gs[4], sh[4], gt[4];
#pragma unroll
        for (int j = 0; j < 4; ++j) { const int c = 4 * lane + 256 * j; const f32x4 gg = *(const f32x4*)(gvec + c);
            if (FINAL) { gs[j] = gg; sh[j] = (f32x4){0.f, 0.f, 0.f, 0.f}; }
            else { const float* shift = mod + (size_t)b * NMODC + (sub * 3 + 0) * D; gs[j] = gg * (*(const f32x4*)(shift + D + c) + 1.0f); sh[j] = *(const f32x4*)(shift + c); }
            if (HASD) gt[j] = *(const f32x4*)(gate0 + (size_t)b * NMODC + c) * s; }
        f32x4 v[4], nx[4], nx2[4]; u32x2 dl[4], nd[4], nd2[4];
        { const f32x4* xr = (const f32x4*)(Xin + (size_t)r0 * D) + lane; const u32x2* dr = (const u32x2*)(delta + (size_t)r0 * D) + lane;
#pragma unroll
          for (int j = 0; j < 4; ++j) { v[j] = __builtin_nontemporal_load(xr + 64 * j); if (HASD) dl[j] = __builtin_nontemporal_load(dr + 64 * j); }
#pragma unroll
          for (int j = 0; j < 4; ++j) { nx[j] = __builtin_nontemporal_load(xr + 64 * j + D / 4); if (HASD) nd[j] = __builtin_nontemporal_load(dr + 64 * j + D / 4); } }
        for (int r = r0; r < r0 + 16; ++r) {
            if (r + 2 < r0 + 16) { const f32x4* xr = (const f32x4*)(Xin + (size_t)(r + 2) * D) + lane; const u32x2* dr = (const u32x2*)(delta + (size_t)(r + 2) * D) + lane;
#pragma unroll
                for (int j = 0; j < 4; ++j) { nx2[j] = __builtin_nontemporal_load(xr + 64 * j); if (HASD) nd2[j] = __builtin_nontemporal_load(dr + 64 * j); } }
            float ss = 0.f;
#pragma unroll
            for (int j = 0; j < 4; ++j) {
                if (HASD) { const f32x4 d = (f32x4){bflo(dl[j].x), bfhi(dl[j].x), bflo(dl[j].y), bfhi(dl[j].y)}; v[j] += gt[j] * d; }
                ss += (v[j].x * v[j].x + v[j].y * v[j].y) + (v[j].z * v[j].z + v[j].w * v[j].w); }
            const float rstd = 1.0f / sqrtf(wave_sum(ss) * (1.0f / D) + EPS);
            if (FINAL) {
#pragma unroll
                for (int j = 0; j < 4; ++j) wt_store16<18>(v[j] * rstd * gs[j], wt_rsrc(Xout, (unsigned)M * D * 4u), (unsigned)r * (D * 4u) + (unsigned)lane * 16u + j * 1024u); }
            else {
                if (WRX && !XOUTB) {
#pragma unroll
                    for (int j = 0; j < 4; ++j) wt_store16<18>(v[j], wt_rsrc(Xout, (unsigned)M * D * 4u), (unsigned)r * (D * 4u) + (unsigned)lane * 16u + j * 1024u); }
                if (WRX && XOUTB) {
#pragma unroll
                    for (int j = 0; j < 4; ++j) { u32x2 w; w.x = cvt_pk_bf16(v[j].x, v[j].y); w.y = cvt_pk_bf16(v[j].z, v[j].w); wt_store8<18>(w, wt_rsrc(Xout, (unsigned)M * D * 2u), (unsigned)r * (D * 2u) + (unsigned)lane * 8u + j * 512u); } }
#pragma unroll
                for (int j = 0; j < 4; ++j) { const f32x4 o = v[j] * rstd * gs[j] + sh[j]; u32x2 w; w.x = cvt_pk_bf16(o.x, o.y); w.y = cvt_pk_bf16(o.z, o.w); wt_store8<16>(w, wt_rsrc(Hout, (unsigned)M * D * 2u), (unsigned)r * (D * 2u) + (unsigned)lane * 8u + j * 512u); } }
#pragma unroll
            for (int j = 0; j < 4; ++j) { v[j] = nx[j]; nx[j] = nx2[j]; if (HASD) { dl[j] = nd[j]; nd[j] = nd2[j]; } }
        }
    }
}

__device__ __forceinline__ void norm_mod_phase(const float* X, const float* gvec, const float* mod, int sub, bf16_t* Hout, int gw, int ngw, int lane) {
    for (int blk = gw; blk < M / 16; blk += ngw) {
        const int r0 = blk * 16, b = r0 / SEQ;
        const float* shift = mod + (size_t)b * NMODC + (sub * 3 + 0) * D; const float* scale = shift + D;
        f32x4 gs[4], sh[4];
#pragma unroll
        for (int j = 0; j < 4; ++j) { const int c = 4 * lane + 256 * j; const f32x4 gg = *(const f32x4*)(gvec + c), sc = *(const f32x4*)(scale + c); gs[j] = gg * (sc + 1.0f); sh[j] = *(const f32x4*)(shift + c); }
        f32x4 v[4], nx[4];
        { const f32x4* xr = (const f32x4*)(X + (size_t)r0 * D) + lane;
#pragma unroll
          for (int j = 0; j < 4; ++j) v[j] = xr[64 * j]; }
        for (int r = r0; r < r0 + 16; ++r) {
            if (r + 1 < r0 + 16) { const f32x4* xr = (const f32x4*)(X + (size_t)(r + 1) * D) + lane;
#pragma unroll
                for (int j = 0; j < 4; ++j) nx[j] = xr[64 * j]; }
            float s = 0.f;
#pragma unroll
            for (int j = 0; j < 4; ++j) s += (v[j].x * v[j].x + v[j].y * v[j].y) + (v[j].z * v[j].z + v[j].w * v[j].w);
            const float rstd = 1.0f / sqrtf(wave_sum(s) * (1.0f / D) + EPS);
            u32x2* o8 = (u32x2*)(Hout + (size_t)r * D) + lane;
#pragma unroll
            for (int j = 0; j < 4; ++j) { const f32x4 o = v[j] * rstd * gs[j] + sh[j]; u32x2 w; w.x = cvt_pk_bf16(o.x, o.y); w.y = cvt_pk_bf16(o.z, o.w); o8[64 * j] = w; }
#pragma unroll
            for (int j = 0; j < 4; ++j) v[j] = nx[j];
        }
    }
}

__device__ __forceinline__ void resid_xg_pass(const float* Xin, const bf16_t* delta, const float* gate0, float s, float* Xout, const float* gvec, const float* mod, int sub, bf16_t* Hout, float* rss, int gw, int ngw, int lane) {
    for (int blk = gw; blk < M / 16; blk += ngw) {
        const int r0 = blk * 16, b = r0 / SEQ;
        f32x4 gs[4], gt[4];
#pragma unroll
        for (int j = 0; j < 4; ++j) { const int c = 4 * lane + 256 * j; const float* shift = mod + (size_t)b * NMODC + (sub * 3 + 0) * D;
            gs[j] = *(const f32x4*)(gvec + c) * (*(const f32x4*)(shift + D + c) + 1.0f); gt[j] = *(const f32x4*)(gate0 + (size_t)b * NMODC + c) * s; }
        f32x4 v[4], nx[4], nx2[4]; u32x2 dl[4], nd[4], nd2[4];
        { const f32x4* xr = (const f32x4*)(Xin + (size_t)r0 * D) + lane; const u32x2* dr = (const u32x2*)(delta + (size_t)r0 * D) + lane;
#pragma unroll
          for (int j = 0; j < 4; ++j) { v[j] = __builtin_nontemporal_load(xr + 64 * j); dl[j] = __builtin_nontemporal_load(dr + 64 * j); }
#pragma unroll
          for (int j = 0; j < 4; ++j) { nx[j] = __builtin_nontemporal_load(xr + 64 * j + D / 4); nd[j] = __builtin_nontemporal_load(dr + 64 * j + D / 4); } }
        for (int r = r0; r < r0 + 16; ++r) {
            if (r + 2 < r0 + 16) { const f32x4* xr = (const f32x4*)(Xin + (size_t)(r + 2) * D) + lane; const u32x2* dr = (const u32x2*)(delta + (size_t)(r + 2) * D) + lane;
#pragma unroll
                for (int j = 0; j < 4; ++j) { nx2[j] = __builtin_nontemporal_load(xr + 64 * j); nd2[j] = __builtin_nontemporal_load(dr + 64 * j); } }
            float ss = 0.f;
#pragma unroll
            for (int j = 0; j < 4; ++j) { const f32x4 d = (f32x4){bflo(dl[j].x), bfhi(dl[j].x), bflo(dl[j].y), bfhi(dl[j].y)}; v[j] += gt[j] * d;
                ss += (v[j].x * v[j].x + v[j].y * v[j].y) + (v[j].z * v[j].z + v[j].w * v[j].w); }
            ss = wave_sum(ss);
            if (lane < 16) rss[(size_t)r * 16 + lane] = (lane == 0) ? ss : 0.f;
#pragma unroll
            for (int j = 0; j < 4; ++j) { wt_store16<18>(v[j], wt_rsrc(Xout, (unsigned)M * D * 4u), (unsigned)r * (D * 4u) + (unsigned)lane * 16u + j * 1024u);
                const f32x4 o = v[j] * gs[j]; u32x2 w; w.x = cvt_pk_bf16(o.x, o.y); w.y = cvt_pk_bf16(o.z, o.w); wt_store8<16>(w, wt_rsrc(Hout, (unsigned)M * D * 2u), (unsigned)r * (D * 2u) + (unsigned)lane * 8u + j * 512u); }
#pragma unroll
            for (int j = 0; j < 4; ++j) { v[j] = nx[j]; nx[j] = nx2[j]; dl[j] = nd[j]; nd[j] = nd2[j]; }
        }
    }
}

template <int W> __device__ __forceinline__ void zpass_group(const bf16_t* UP, bf16_t* Z, int tb, int k, int lane) {
    const int cl = lane & 15, tq = lane >> 4;
    const int t0 = tb * 16 + tq * 4, tin = t0 & (SEQ - 1), c0 = k * 128 + cl * 8;
    constexpr int NR = W + 3;
    u32x4 rows[NR];
#pragma unroll
    for (int j = 0; j < NR; ++j) { const int dt = j - (W - 1);
        rows[j] = (tin + dt >= 0) ? *(const u32x4*)(UP + (size_t)(t0 + dt) * PWID + c0) : (u32x4){0u, 0u, 0u, 0u}; }
    f32x4 s0 = (f32x4){0.f, 0.f, 0.f, 0.f}, s1 = s0;
#pragma unroll
    for (int j = 0; j < W; ++j) { f32x4 a0, a1; pg8::unpack8(rows[j], a0, a1); s0 += a0; s1 += a1; }
#pragma unroll
    for (int i = 0; i < 4; ++i) {
        f32x4 c0v, c1v; pg8::unpack8(rows[W - 1 + i], c0v, c1v);
        if (i > 0) { f32x4 o0, o1; pg8::unpack8(rows[i - 1], o0, o1); s0 += c0v - o0; s1 += c1v - o1; }
        const int cnt = (tin + i + 1 < W) ? (tin + i + 1) : W; const float inv = 1.0f / (float)cnt;
        *(u32x4*)(Z + (size_t)(t0 + i) * PWID + c0) = pg8::pack8(s0 * inv - c0v, s1 * inv - c1v);
    }
}

__device__ __forceinline__ void final_pass_bf16x(const bf16_t* Xb, const bf16_t* delta, const float* gate0, float s, float* out, const float* gvec, int blk, int lane) {
    const int r0 = blk * 16, b = r0 / SEQ;
    f32x4 gs[4], gt[4];
#pragma unroll
    for (int j = 0; j < 4; ++j) { const int c = 4 * lane + 256 * j; gs[j] = *(const f32x4*)(gvec + c); gt[j] = *(const f32x4*)(gate0 + (size_t)b * NMODC + c) * s; }
    u32x2 xa[4], xn1[4], xn2[4], da[4], dn1[4], dn2[4];
    { const u32x2* xr = (const u32x2*)(Xb + (size_t)r0 * D) + lane; const u32x2* dr = (const u32x2*)(delta + (size_t)r0 * D) + lane;
#pragma unroll
      for (int j = 0; j < 4; ++j) { xa[j] = __builtin_nontemporal_load(xr + 64 * j); da[j] = __builtin_nontemporal_load(dr + 64 * j); }
#pragma unroll
      for (int j = 0; j < 4; ++j) { xn1[j] = __builtin_nontemporal_load(xr + 64 * j + D / 4); dn1[j] = __builtin_nontemporal_load(dr + 64 * j + D / 4); } }
    for (int r = r0; r < r0 + 16; ++r) {
        if (r + 2 < r0 + 16) { const u32x2* xr = (const u32x2*)(Xb + (size_t)(r + 2) * D) + lane; const u32x2* dr = (const u32x2*)(delta + (size_t)(r + 2) * D) + lane;
#pragma unroll
            for (int j = 0; j < 4; ++j) { xn2[j] = __builtin_nontemporal_load(xr + 64 * j); dn2[j] = __builtin_nontemporal_load(dr + 64 * j); } }
        f32x4 v[4]; float ss = 0.f;
#pragma unroll
        for (int j = 0; j < 4; ++j) { const f32x4 x = (f32x4){bflo(xa[j].x), bfhi(xa[j].x), bflo(xa[j].y), bfhi(xa[j].y)}, d = (f32x4){bflo(da[j].x), bfhi(da[j].x), bflo(da[j].y), bfhi(da[j].y)};
            v[j] = x + gt[j] * d; ss += (v[j].x * v[j].x + v[j].y * v[j].y) + (v[j].z * v[j].z + v[j].w * v[j].w); }
        const float rstd = 1.0f / sqrtf(wave_sum(ss) * (1.0f / D) + EPS);
#pragma unroll
        for (int j = 0; j < 4; ++j) wt_store16<18>(v[j] * rstd * gs[j], wt_rsrc(out, (unsigned)M * D * 4u), (unsigned)r * (D * 4u) + (unsigned)lane * 16u + j * 1024u);
#pragma unroll
        for (int j = 0; j < 4; ++j) { xa[j] = xn1[j]; xn1[j] = xn2[j]; da[j] = dn1[j]; dn1[j] = dn2[j]; }
    }
}

constexpr int LDS_BYTES = 163840;
constexpr int LDS_RSTD = 131072 + 1024, LDS_SWT = LDS_RSTD + 11 * 1024, MAXU = 11;
template <class Sched> __device__ __forceinline__ void fill_norm_tables(LAS unsigned char* lds, const Sched& S, const float* rss, const float* sW, int nw, int tid) {
    LAS float* rstdL = (LAS float*)(lds + LDS_RSTD); LAS float* swL = (LAS float*)(lds + LDS_SWT);
    constexpr int NU = 6;
    pg8::Unit u[NU]; bool ok[NU]; f32x4 q[NU]; float sv[NU];
#pragma unroll
    for (int ui = 0; ui < NU; ++ui) { ok[ui] = S.next(ui, u[ui]); q[ui] = (f32x4){0.f, 0.f, 0.f, 0.f}; sv[ui] = 0.f;
        if (ok[ui]) { if (tid < 256) { const f32x4* p = (const f32x4*)(rss + (size_t)(u[ui].pm * 256 + tid) * 16); q[ui] = (p[0] + p[1]) + (p[2] + p[3]); }
                      else sv[ui] = sW[(size_t)(u[ui].pm >> 4) * nw + u[ui].pn * 256 + tid - 256]; } }
#pragma unroll
    for (int ui = 0; ui < NU; ++ui) if (ok[ui]) { if (tid < 256) rstdL[ui * 256 + tid] = 1.0f / sqrtf(((q[ui].x + q[ui].y) + (q[ui].z + q[ui].w)) * (1.0f / D) + EPS); else swL[ui * 256 + tid - 256] = sv[ui]; }
    __syncthreads();
}

__global__ void __launch_bounds__(512, 2) mega_fwd(Args a) {
    extern __shared__ __attribute__((aligned(16))) unsigned char lds_raw[];
    LAS unsigned char* lds = (LAS unsigned char*)lds_raw;
    cg::grid_group grid = cg::this_grid();
    const int G = gridDim.x, bid = blockIdx.x, ngw = G * 8;
#define PHASE_IDS int tid = threadIdx.x; asm volatile("" : "+v"(tid)); const int lane = tid & 63, wave = __builtin_amdgcn_readfirstlane(tid >> 6), gw = bid * 8 + wave; \
    LAS float* scr = (LAS float*)(lds + wave * 16384); (void)lane; (void)gw; (void)scr;
#define x_in (a.in[0])
#define X (a.out)
#define mod ((float*)(a.ws + WS_MOD))
#define part ((float*)(a.ws + WS_PART))
#define W1IN ((bf16_t*)(a.ws + WS_W1IN))
#define W1OUT ((bf16_t*)(a.ws + WS_W1OUT))
#define WIN ((bf16_t*)(a.ws + WS_WIN))
#define WPOOL ((bf16_t*)(a.ws + WS_WPOOL))
#define WPUP ((bf16_t*)(a.ws + WS_WPUP))
#define WGLU ((bf16_t*)(a.ws + WS_WGLU))
#define WSUP ((bf16_t*)(a.ws + WS_WSUP))
#define WOUT ((bf16_t*)(a.ws + WS_WOUT))
#define W2IN ((bf16_t*)(a.ws + WS_W2IN))
#define W2OUT ((bf16_t*)(a.ws + WS_W2OUT))
#define BTE ((bf16_t*)(a.ws + WS_BTE))
#define BTY ((bf16_t*)(a.ws + WS_BTY))
#define Hb ((bf16_t*)(a.ws + WS_H))
#define ACT ((bf16_t*)(a.ws + WS_ACT))
#define UPOOL ((bf16_t*)(a.ws + WS_UPOOL))
#define ASSM ((bf16_t*)(a.ws + WS_ASSM))
#define Zb ((bf16_t*)(a.ws + WS_Z))
#define ZP ((bf16_t*)(a.ws + WS_ZP))
#define Eb ((float*)(a.ws + WS_E))
#define YG ((bf16_t*)(a.ws + WS_YG))
#define SG ((bf16_t*)(a.ws + WS_SG))
#define SIGP ((bf16_t*)(a.ws + WS_SIGP))
#define SIGS ((bf16_t*)(a.ws + WS_SIGS))
#define MERGED Hb
#define DELTA SIGP
#define RSS ((float*)(a.ws + WS_RSS))
#define SWIN ((float*)(a.ws + WS_SW))
#define SW2 (SWIN + BATCH * 3072)
    volatile LAS unsigned* MISC = (volatile LAS unsigned*)(lds + 131072 + 320);
    if (threadIdx.x < 16) MISC[threadIdx.x] = 0u;
    __syncthreads();
    const XcdBarrier xbar = xcd_barrier_post((unsigned*)(a.ws + WS_BAR), MISC + 8);
#define GRID_BAR() xcd_barrier(xbar)

    { PHASE_IDS
    for (int w = bid; w < NG * 8; w += G) ssm_prep_stage1(a, w >> 3, w & 7, (LAS float*)lds, tid);
    {
        const float* cvec = a.in[1]; const float* w_ada = a.in[2];
        for (int it = bid + G * wave; it < MODKC * 36 && wave < 3; it += 3 * G) {
            const int kc = it / 36, cb = it % 36;
#pragma unroll
            for (int b = 0; b < BATCH; ++b) { const float v = cvec[b * D + kc * 64 + lane]; scr[b * 64 + lane] = v * sigm(v); }
            LDS_WAIT();
            f32x4 acc[BATCH];
#pragma unroll
            for (int b = 0; b < BATCH; ++b) acc[b] = (f32x4){0.f, 0.f, 0.f, 0.f};
            const float* wp = w_ada + (size_t)(kc * 64) * NMODC + cb * 256;
            const unsigned lo4 = (unsigned)lane * 4u;
#pragma unroll 8
            for (int k = 0; k < 64; ++k) { const f32x4 w = __builtin_nontemporal_load((const f32x4*)((wp + (size_t)k * NMODC) + lo4));
#pragma unroll
                for (int b = 0; b < BATCH; ++b) acc[b] += w * scr[b * 64 + k]; }
#pragma unroll
            for (int b = 0; b < BATCH; ++b) *(f32x4*)(part + (size_t)(kc * BATCH + b) * NMODC + cb * 256 + lane * 4) = acc[b];
            LDS_WAIT();
        }
    }
    {
        constexpr int I1 = (D / 64) * (2 * FF / 32), I2 = (FF / 64) * (D / 32), I3 = (D / 64) * (3072 / 32), I4 = 4 * 2 * 4, I5 = (512 / 64) * (D / 32), I8 = (D / 64) * (D / 32);
        constexpr int NIT = 2 * I1 + 2 * I2 + I3 + I4 + 3 * I5 + I8;
        const int nmod = (bid + 2 * G < MODKC * 36) ? 3 : ((bid + G < MODKC * 36) ? 2 : ((bid < MODKC * 36) ? 1 : 0));
        const int nper = (NIT - bid + G - 1) / G;
        const int J1 = (nmod >= 8) ? 0 : ((nper * (8 - nmod) * 13) / (8 * 13 - nmod * 8) < nper ? (nper * (8 - nmod) * 13) / (8 * 13 - nmod * 8) : nper);
        const bool ismod = wave < nmod;
        const int jstart = ismod ? J1 + wave : wave - nmod, jstep = ismod ? nmod : 8 - nmod, jend = ismod ? nper : J1;
        for (int j = jstart; j < jend; j += jstep) {
            const int it = bid + G * j;
            int r = it;
            if (r < I1) { transpose_item(a.in[5], D, 2 * FF, W1IN, FF, r, scr, lane); continue; } r -= I1;
            if (r < I1) { transpose_item(a.in[26], D, 2 * FF, W2IN, FF, r, scr, lane); continue; } r -= I1;
            if (r < I2) { transpose_item(a.in[6], FF, D, W1OUT, 0, r, scr, lane); continue; } r -= I2;
            if (r < I2) { transpose_item(a.in[27], FF, D, W2OUT, 0, r, scr, lane); continue; } r -= I2;
            if (r < I3) { transpose_item(a.in[8], D, 3072, WIN, 0, r, scr, lane); continue; } r -= I3;
            if (r < I4) { const int k = r >> 3, q = r & 7, kb = q >> 2, nb = q & 3;
                transpose_block(a.in[9] + (size_t)k * 128 * 128, 128, WPOOL + (size_t)(k * 128) * PWID + k * 128, PWID, 64 * kb, 32 * nb, 32 * nb, scr, lane); continue; } r -= I4;
            if (r < I5) { transpose_item(a.in[12], 512, D, WPUP, 0, r, scr, lane); continue; } r -= I5;
            if (r < I5) { transpose_item(a.in[21], 512, D, WGLU, 512, r, scr, lane); continue; } r -= I5;
            if (r < I5) { transpose_item(a.in[23], 512, D, WSUP, 0, r, scr, lane); continue; } r -= I5;
            transpose_item(a.in[24], D, D, WOUT, 0, r, scr, lane);
        }
        for (int q = bid * 512 + tid; q < 12 * 128 * 16; q += G * 512) { const int blk = q / 2048, rem = q % 2048, row = rem >> 4, ch = rem & 15;
            const int kr = blk / 3, kk = blk % 3, kc = kk + (kk >= kr ? 1 : 0);
            *(u32x4*)(WPOOL + (size_t)(kr * 128 + row) * PWID + kc * 128 + ch * 8) = (u32x4){0u, 0u, 0u, 0u}; }
    }
    }
    if (a.ws == nullptr) grid.sync();
    GRID_BAR();
    { PHASE_IDS
        const float* b_ada = a.in[3];
        {
            const int bb = bid >> 5;
            for (int i = tid; i < 2 * D; i += 512) { float s = b_ada[i];
#pragma unroll
                for (int kc = 0; kc < MODKC; ++kc) s += part[(size_t)(kc * BATCH + bb) * NMODC + i];
                mod[(size_t)bb * NMODC + i] = s; }
            for (int i = bid * 512 + tid; i < BATCH * NMODC; i += G * 512) { float s = b_ada[i % NMODC];
#pragma unroll
                for (int kc = 0; kc < MODKC; ++kc) s += part[(size_t)kc * BATCH * NMODC + i];
                mod[i] = s; }
            asm volatile("s_waitcnt vmcnt(0)" ::: "memory"); __syncthreads();
        }
        row_pass<false, false, false>(x_in, Hb, mod, 0.f, X, a.in[4], mod, 0, Hb, gw, ngw, lane);
        const float* KTg = (const float*)(a.ws + WS_KT);
        for (int q0 = bid * 512 + tid; q0 < NG * 512 * 64; q0 += 4 * G * 512) {
            f32x4 k0[4], k1[4];
#pragma unroll
            for (int e = 0; e < 4; ++e) { const int q = q0 + e * G * 512, g = q >> 15, row = (q >> 6) & 511, ch = q & 63, t = row >> 4, h = row & 15, s = ch >> 1, hp0 = (ch & 1) * 8;
                k0[e] = (f32x4){0.f, 0.f, 0.f, 0.f}; k1[e] = k0[e];
                if (t >= s) { const float* kp = KTg + (size_t)g * (CL * 256) + (t - s) * 256 + h * 16 + hp0; k0[e] = *(const f32x4*)kp; k1[e] = *(const f32x4*)(kp + 4); } }
#pragma unroll
            for (int e = 0; e < 4; ++e) { const int q = q0 + e * G * 512, g = q >> 15, row = (q >> 6) & 511, ch = q & 63, s = ch >> 1, hp0 = (ch & 1) * 8;
                *(u32x4*)(BTY + ((size_t)(g * 512 + row) * KA + s * GH + hp0)) = pg8::pack8(k0[e], k1[e]); } }
    }
    GRID_BAR();
    {
        pg8::Gemm g{Hb, W1IN, D, D, D, 0}; pg8::StaticOrder S; S.init(M, 2 * FF, G, bid);
        pg8::EpiSwiGLU<false> E{ACT, FF, nullptr, nullptr};
        pg8::gemm_phase<pg8::EpiSwiGLU<false>, pg8::StaticOrder, true>(lds, g, S, E);
    }
    GRID_BAR();
    {
        pg8::Gemm g{ACT, W1OUT, FF, FF, FF, 0}; pg8::StaticOrder S; S.init(M, D, G, bid);
        pg8::EpiPlain E{DELTA, D};
        pg8::gemm_phase<pg8::EpiPlain, pg8::StaticOrder, true>(lds, g, S, E);
    }
    GRID_BAR();
    { PHASE_IDS
    {
        for (int row = gw; row < 3072; row += ngw) {
            const bf16_t* wrow = WIN + (size_t)row * D;
            f32x4 w[4]; { f32x4 t0, t1; pg8::unpack8(*(const u32x4*)(wrow + 8 * lane), t0, t1); w[0] = t0; w[1] = t1; pg8::unpack8(*(const u32x4*)(wrow + 512 + 8 * lane), t0, t1); w[2] = t0; w[3] = t1; }
            f32x4 sh4[BATCH][4];
#pragma unroll
            for (int b = 0; b < BATCH; ++b) { const float* sh = mod + (size_t)b * NMODC + (1 * 3 + 0) * D;
                sh4[b][0] = *(const f32x4*)(sh + 8 * lane); sh4[b][1] = *(const f32x4*)(sh + 8 * lane + 4); sh4[b][2] = *(const f32x4*)(sh + 512 + 8 * lane); sh4[b][3] = *(const f32x4*)(sh + 512 + 8 * lane + 4); }
#pragma unroll
            for (int b = 0; b < BATCH; ++b) { const f32x4 pr = (w[0] * sh4[b][0] + w[1] * sh4[b][1]) + (w[2] * sh4[b][2] + w[3] * sh4[b][3]);
                const float tot = wave_sum((pr.x + pr.y) + (pr.z + pr.w));
                if (lane == 0) SWIN[(size_t)b * 3072 + row] = tot; }
        }
    }
    resid_xg_pass(x_in, DELTA, mod + (0 * 3 + 2) * D, 0.5f, X, a.in[7], mod, 1, Hb, RSS, (bid & 7) * 256 + (bid >> 3) * 8 + wave, ngw, lane);
    }
    GRID_BAR();
    {
        pg8::Gemm g{Hb, WIN, D, D, D, 0}; pg8::StaticOrder S; S.init(M, 3072, G, bid);
        { PHASE_IDS fill_norm_tables(lds, S, RSS, SWIN, 3072, tid); }
        pg8::EpiWin E{UPOOL, ASSM, SIGP, SIGS, (const LAS float*)(lds + LDS_RSTD), (const LAS float*)(lds + LDS_SWT)};
        pg8::gemm_phase<pg8::EpiWin, pg8::StaticOrder, true>(lds, g, S, E);
    }
    GRID_BAR();
    {
        { PHASE_IDS
        const int slot = bid >> 3; const bool split = (G == 256);
        const int zw = split ? ((slot - 16) * 8 + (bid & 7)) * 8 + wave : gw, nzw = split ? 1024 : ngw;
        if (!split || slot >= 16)
            for (int tb = zw; tb < M / 16; tb += nzw) { zpass_group<2>(UPOOL, Zb, tb, 0, lane); zpass_group<4>(UPOOL, Zb, tb, 1, lane); zpass_group<8>(UPOOL, Zb, tb, 2, lane); zpass_group<16>(UPOOL, Zb, tb, 3, lane); } }
        pg8::Gemm g{ASSM, BTE, KA, 512, 512, 0}; pg8::OrderE S{G, bid};
        pg8::EpiE E{Eb};
        pg8::gemm_phase<pg8::EpiE, pg8::OrderE, false>(lds, g, S, E);
    }
    GRID_BAR();
    {
        { PHASE_IDS
        const float* A32 = (const float*)(a.ws + WS_A32);
        LAS float* EL = (LAS float*)lds; LAS bf16_t* OL = (LAS bf16_t*)(lds + 65536);
        for (int item = bid; item < NG * BATCH; item += G) {
            const int g = item >> 3, b = item & 7; const size_t row0 = (size_t)g * RPG + b * NCH;
            const f32x4* src = (const f32x4*)(Eb + row0 * 128);
            f32x4 ev[8];
#pragma unroll
            for (int i = 0; i < 8; ++i) ev[i] = src[tid + 512 * i];
#pragma unroll
            for (int i = 0; i < 8; ++i) *(LAS f32x4*)(EL + 4 * (tid + 512 * i)) = ev[i];
            __syncthreads();
            if (wave == 0) { const int n = lane;
                const float ar = A32[(g * NS + n) * 2], ai = A32[(g * NS + n) * 2 + 1];
                float sr = 0.f, si = 0.f;
#pragma unroll 8
                for (int c = 0; c < NCH; ++c) { const float er = EL[c * 128 + n], ei = EL[c * 128 + 64 + n];
                    OL[c * 128 + n] = (bf16_t)f2bf(sr); OL[c * 128 + 64 + n] = (bf16_t)f2bf(si);
                    const float q = ar * sr - ai * si + er; si = ar * si + ai * sr + ei; sr = q; } }
            __syncthreads();
#pragma unroll
            for (int i = 0; i < 4; ++i) { const int q = tid + 512 * i, c = q >> 4, k = q & 15;
                *(u32x4*)(ASSM + (row0 + c) * KA + 512 + k * 8) = *(const LAS u32x4*)(OL + c * 128 + k * 8); }
            __syncthreads();
        } }
        pg8::Gemm g{Zb, WPOOL, PWID, PWID, 256, 256 * 2};     pg8::StaticOrder S; S.init(M, PWID, G, bid);
        pg8::EpiPool1 E{ZP, a.in[10], a.in[11]};
        pg8::gemm_phase<pg8::EpiPool1, pg8::StaticOrder, false>(lds, g, S, E);
    }
    GRID_BAR();
    {
        { pg8::Gemm g{ASSM, BTY, KA, KA, KA, 0}; pg8::OrderY S{G, bid}; pg8::EpiY E{YG, ASSM, a.in[20]};
          pg8::gemm_phase<pg8::EpiY, pg8::OrderY, false>(lds, g, S, E); }
        { pg8::Gemm g{ZP, WPUP, PWID, PWID, PWID, 0}; pg8::StaticOrder S; S.init(M, D, G, bid); pg8::EpiGateAcc<false> E{MERGED, SIGP};
          pg8::gemm_phase<pg8::EpiGateAcc<false>, pg8::StaticOrder, true>(lds, g, S, E); }
    }
    GRID_BAR();
    {
        pg8::Gemm g{YG, WGLU, SWID, SWID, SWID, 0}; pg8::StaticOrder S; S.init(M, 2 * SWID, G, bid);
        pg8::EpiGLU E{SG, SWID, a.in[22], SWID};
        pg8::gemm_phase<pg8::EpiGLU, pg8::StaticOrder, true>(lds, g, S, E);
    }
    GRID_BAR();
    {
        pg8::Gemm g{SG, WSUP, SWID, SWID, SWID, 0}; pg8::StaticOrder S; S.init(M, D, G, bid);
        pg8::EpiGateAcc<true> E{MERGED, SIGS};
        pg8::gemm_phase<pg8::EpiGateAcc<true>, pg8::StaticOrder, true>(lds, g, S, E);
    }
    GRID_BAR();
    {
        pg8::Gemm g{MERGED, WOUT, D, D, D, 0}; pg8::StaticOrder S; S.init(M, D, G, bid);
        pg8::EpiPlain E{DELTA, D};
        pg8::gemm_phase<pg8::EpiPlain, pg8::StaticOrder, true>(lds, g, S, E);
    }
    GRID_BAR();
    { PHASE_IDS
    row_pass<true, true, false, true>(X, DELTA, mod + (1 * 3 + 2) * D, 1.0f, (float*)SIGS  , a.in[25], mod, 2, Hb, (bid & 7) * 256 + (bid >> 3) * 8 + wave, ngw, lane);
    }
    GRID_BAR();
    {
        pg8::Gemm g{Hb, W2IN, D, D, D, 0}; pg8::StaticOrder S; S.init(M, 2 * FF, G, bid);
        pg8::EpiSwiGLU<false> E{ACT, FF, nullptr, nullptr};
        pg8::gemm_phase<pg8::EpiSwiGLU<false>, pg8::StaticOrder, true>(lds, g, S, E);
    }
    GRID_BAR();
    {
        pg8::Gemm g{ACT, W2OUT, FF, FF, FF, 0}; pg8::StaticOrder S; S.init(M, D, G, bid);
        pg8::EpiPlain E{DELTA, D};
        pg8::gemm_phase<pg8::EpiPlain, pg8::StaticOrder, true>(lds, g, S, E);
    }
    GRID_BAR();
    { PHASE_IDS
    final_pass_bf16x(SIGS, DELTA, mod + (2 * 3 + 2) * D, 0.5f, X, a.in[28], (bid & 7) * 256 + (bid >> 3) * 8 + wave, lane);
    }
}

extern "C" void kernel_launch(void* const* d_in, const int* in_sizes, int n_in, void* d_out, int out_size, void* d_ws, size_t ws_size, hipStream_t stream) {
    static int grid_blocks = 0;
    if (grid_blocks == 0) {
        if (n_in != 29 || out_size != M * D || ws_size < WS_END) { fprintf(stderr, "kernel_launch: unexpected problem (n_in %d out %d ws %zu)\n", n_in, out_size, ws_size); grid_blocks = -1; return; }
        int dev = 0, cus = 0, per_cu = 0;
        (void)hipGetDevice(&dev);
        (void)hipDeviceGetAttribute(&cus, hipDeviceAttributeMultiprocessorCount, dev);
        (void)hipFuncSetAttribute((const void*)mega_fwd, hipFuncAttributeMaxDynamicSharedMemorySize, LDS_BYTES);
        (void)hipOccupancyMaxActiveBlocksPerMultiprocessor(&per_cu, (const void*)mega_fwd, 512, LDS_BYTES);
        (void)hipGetLastError();
        if (per_cu < 1) per_cu = 1;
        grid_blocks = cus * per_cu;
        if (grid_blocks != 256) { fprintf(stderr, "kernel_launch: built for a 256-workgroup grid (got %d)\n", grid_blocks); grid_blocks = -1; return; }
    }
    if (grid_blocks < 0) return;
    Args a{};
    for (int i = 0; i < 29; ++i) a.in[i] = (const float*)d_in[i];
    a.out = (float*)d_out; a.ws = (unsigned char*)d_ws;
    (void)hipMemsetAsync((unsigned char*)d_ws + WS_BAR, 0, BAR_BYTES, stream);
    void* args[] = {&a};
    hipError_t e = hipLaunchCooperativeKernel((const void*)mega_fwd, dim3(grid_blocks), dim3(512), args, LDS_BYTES, stream);
    if (e != hipSuccess) fprintf(stderr, "cooperative launch failed: %s (grid %d)\n", hipGetErrorString(e), grid_blocks);
}
```

```cpp
#include <hip/hip_runtime.h>
#include <hip/hip_cooperative_groups.h>
#include <cstdio>
namespace cg = cooperative_groups;

#define LAS __attribute__((address_space(3)))
typedef unsigned short bf16_t;
typedef short bf16x8 __attribute__((ext_vector_type(8)));
typedef float f32x4 __attribute__((ext_vector_type(4)));
typedef unsigned u32x4 __attribute__((ext_vector_type(4)));
typedef unsigned u32x2 __attribute__((ext_vector_type(2)));

constexpr int D = 1024, BATCH = 8, SEQ = 4096, M = BATCH * SEQ, FF = 2816, NMODC = 9 * D;
constexpr int PWID = 512, SWID = 512, NG = 32, GH = 16, NS = 64;
constexpr int CL = 32, NCH = SEQ / CL, RPG = BATCH * NCH  , KA = 640  ;
constexpr float EPS = 1e-6f;
constexpr int MODKC = 16;

constexpr size_t MiB = 1u << 20;
constexpr size_t WS_PART = 0, WS_MOD = 5 * MiB, WS_A32 = 5 * MiB + 512 * 1024, WS_BAR = 5 * MiB + 768 * 1024, BAR_BYTES = 16384;
constexpr size_t WS_W1IN = 6 * MiB, WS_W1OUT = 17 * MiB, WS_WIN = 23 * MiB, WS_WPOOL = 29 * MiB, WS_WPUP = 30 * MiB, WS_WGLU = 31 * MiB,
                 WS_WSUP = 32 * MiB, WS_WOUT = 33 * MiB, WS_W2IN = 35 * MiB, WS_W2OUT = 46 * MiB, WS_BTE = 52 * MiB, WS_BTY = 60 * MiB;
constexpr size_t WS_H = 80 * MiB;
constexpr size_t WS_ACT = 144 * MiB;
constexpr size_t WS_UPOOL = 144 * MiB, WS_ASSM = 176 * MiB, WS_Z = 216 * MiB, WS_ZP = 248 * MiB, WS_E = 280 * MiB;
constexpr size_t WS_YG = WS_UPOOL, WS_SG = WS_Z;
constexpr size_t WS_SIGP = 320 * MiB, WS_SIGS = 384 * MiB, WS_RSS = 448 * MiB  , WS_SW = 450 * MiB  , WS_KT = 451 * MiB  , WS_END = 452 * MiB;

__device__ __forceinline__ unsigned cvt_pk_bf16(float lo, float hi) { unsigned r; asm volatile("v_cvt_pk_bf16_f32 %0, %1, %2" : "=v"(r) : "v"(lo), "v"(hi)); return r; }
__device__ __forceinline__ unsigned f2bf(float f) { unsigned u = __builtin_bit_cast(unsigned, f); return (u + 0x7fffu + ((u >> 16) & 1u)) >> 16; }
__device__ __forceinline__ float bflo(unsigned w) { return __builtin_bit_cast(float, w << 16); }
__device__ __forceinline__ float bfhi(unsigned w) { return __builtin_bit_cast(float, w & 0xffff0000u); }
__device__ __forceinline__ float sigm(float x) { return __builtin_amdgcn_rcpf(1.0f + __builtin_amdgcn_exp2f(x * -1.4426950408889634f)); }
typedef float f32x2 __attribute__((ext_vector_type(2)));
__device__ __forceinline__ f32x2 sigm2(f32x2 x) { const f32x2 t = x * -1.4426950408889634f; f32x2 e; e.x = __builtin_amdgcn_exp2f(t.x); e.y = __builtin_amdgcn_exp2f(t.y); const f32x2 d = e + 1.0f; f32x2 r; r.x = __builtin_amdgcn_rcpf(d.x); r.y = __builtin_amdgcn_rcpf(d.y); return r; }
__device__ __forceinline__ f32x4 sigm4(f32x4 x) { const f32x2 lo = sigm2((f32x2){x.x, x.y}), hi = sigm2((f32x2){x.z, x.w}); return (f32x4){lo.x, lo.y, hi.x, hi.y}; }
__device__ __forceinline__ f32x2 gelu_pk(f32x2 v) {
    const f32x2 av = __builtin_elementwise_abs(v), d = av * 0.2316418882f + 1.0f;
    f32x2 t; t.x = __builtin_amdgcn_rcpf(d.x); t.y = __builtin_amdgcn_rcpf(d.y);
    f32x2 q = t * 0.5307027145f + (-0.7265760135f); q = q * t + 0.7107068705f; q = q * t + (-0.142248368f); q = q * t + 0.127414796f; q = q * t;
    const f32x2 s = (v * v) * (-0.72134752044f);
    f32x2 e; e.x = __builtin_amdgcn_exp2f(s.x); e.y = __builtin_amdgcn_exp2f(s.y);
    const f32x2 m = v * (q * e), r = v - m;
    f32x2 o; o.x = v.x < 0.f ? m.x : r.x; o.y = v.y < 0.f ? m.y : r.y; return o;
}
__device__ __forceinline__ __amdgpu_buffer_rsrc_t wt_rsrc(const void* p, unsigned bytes) { return __builtin_amdgcn_make_buffer_rsrc((void*)p, 0, bytes, 0x00020000); }
template <int AUX> __device__ __forceinline__ void wt_store16(f32x4 v, __amdgpu_buffer_rsrc_t r, unsigned off) { __builtin_amdgcn_raw_buffer_store_b128(__builtin_bit_cast(u32x4, v), r, off, 0, AUX); }
template <int AUX> __device__ __forceinline__ void wt_store8(u32x2 v, __amdgpu_buffer_rsrc_t r, unsigned off) { __builtin_amdgcn_raw_buffer_store_b64(v, r, off, 0, AUX); }
__device__ __forceinline__ float wave_sum(float v) {
#pragma unroll
    for (int o = 1; o < 64; o <<= 1) v += __shfl_xor(v, o);
    return v;
}
#define LDS_WAIT() asm volatile("s_waitcnt lgkmcnt(0)" ::: "memory")

namespace pg8 {
constexpr int BM = 256, BK = 64, HALF = 128, HTB = HALF * BK * 2, STAGE_BYTES = 8 * HTB, NXCD = 8, WGM = 8;
__host__ __device__ __forceinline__ int lds_byte(int r, int c) { const int st = (r >> 4) * 2 + (c >> 5), rr = r & 15, cc = c & 31, ob = rr * 64 + cc * 2; return st * 1024 + (ob ^ (((ob >> 9) & 1) << 5)); }
__host__ __device__ __forceinline__ void stage_rc(int b, int& R, int& C) { const int st = b / 1024, sb = b % 1024, swz = sb ^ (((sb >> 9) & 1) << 5); R = (st >> 1) * 16 + swz / 64; C = (st & 1) * 32 + (swz % 64) / 2; }
__host__ __device__ __forceinline__ int perm32(int rho) { const int n = rho >> 4, i = rho & 15; return 8 * (i >> 2) + 4 * n + (i & 3); }

struct Unit { int pm, pn; };
struct Gemm { const bf16_t* A; const bf16_t* Bt; int lda, ldb, K; int kpn; };

struct StaticOrder {
    int nM, nN, nwg, G, c;
    __device__ void init(int Mr, int Nc, int G_, int c_) { nM = Mr / BM; nN = Nc / BM; nwg = nM * nN; G = G_; c = c_; }
    __device__ bool next(int i, Unit& u) const {
        const long L = (long)i * G + c; if (L >= nwg) return false;
        int wgid = (int)L; { const int q = nwg / NXCD, r = nwg % NXCD, xcd = wgid % NXCD, off = wgid / NXCD; wgid = (xcd < r ? xcd * (q + 1) : r * (q + 1) + (xcd - r) * q) + off; }
        const int nig = WGM * nN, gid = wgid / nig, fm = gid * WGM, gsz = (nM - fm) < WGM ? (nM - fm) : WGM;
        u.pm = fm + ((wgid % nig) % gsz); u.pn = (wgid % nig) / gsz; return true;
    }
};
struct OrderE {
    int G, c;
    __device__ bool next(int i, Unit& u) const { const int xcd = c & 7, slot = c >> 3; if (i > 0 || G != 256 || slot >= 16) return false; const int g = xcd * 4 + (slot >> 2); u.pm = g * 4 + (slot & 3); u.pn = g; return true; }
};
struct OrderY {
    int G, c;
    __device__ bool next(int i, Unit& u) const { const int xcd = c & 7, slot = c >> 3; if (i > 0 || G != 256) return false; const int g = xcd * 4 + (slot >> 3), rem = slot & 7; u.pm = g * 4 + (rem & 3); u.pn = g * 2 + (rem >> 2); return true; }
};

template <class Epi, class Sched, bool ALIGN_EPI>
__device__ __forceinline__ void gemm_phase(LAS unsigned char* lds, const Gemm g, const Sched& S, const Epi& E) {
    int tid_ = threadIdx.x; asm volatile("" : "+v"(tid_));
    const int tid = tid_, wid = __builtin_amdgcn_readfirstlane(tid >> 6), lane = tid & 63, wr = wid >> 2, wc = wid & 3, fr = lane & 15, fq = lane >> 4;
    const int K = g.K, nt = K / BK;
    unsigned voffA[2], voffB[2];
#pragma unroll
    for (int i = 0; i < 2; ++i) { int R, C; stage_rc(tid * 16 + i * 8192, R, C); const int Rb = Epi::PERM ? ((R & ~31) + perm32(R & 31)) : R;
        voffA[i] = (unsigned)(R * g.lda + C) * 2u; voffB[i] = (unsigned)(Rb * g.ldb + C) * 2u; }
    const size_t kstep = (size_t)(BK * 2);
    const size_t hstepA = (size_t)HALF * g.lda * 2, hstepB = (size_t)HALF * g.ldb * 2;
    const size_t tstepA = 2 * hstepA, tstepB = 2 * hstepB;
    const unsigned ldsw = (unsigned)wid * 1024u;
    const int aoff = lds_byte(wr * 64 + fr, fq * 8), boff = lds_byte(wc * 32 + fr, fq * 8);
#define PG8_SA(b, h) (((b) * 2 + (h)) * HTB)
#define PG8_SB(b, h) ((4 + (b) * 2 + (h)) * HTB)
#define PG8_STAGE(bufoff, gbase, voff) do { _Pragma("unroll") for (int _i = 0; _i < 2; ++_i) \
        __builtin_amdgcn_global_load_lds((const unsigned*)((const char*)(gbase) + (voff)[_i]), (LAS unsigned*)(lds + (bufoff) + ldsw + _i * 8192), 16, 0, 0); } while (0)
#define PG8_LDA(dst, b, h) do { _Pragma("unroll") for (int m = 0; m < 4; ++m) _Pragma("unroll") for (int k = 0; k < 2; ++k) dst[m][k] = *(const LAS bf16x8*)(lds + PG8_SA(b, h) + aoff + m * 2048 + k * 1024); } while (0)
#define PG8_LDB(dst, b, h) do { _Pragma("unroll") for (int n = 0; n < 2; ++n) _Pragma("unroll") for (int k = 0; k < 2; ++k) dst[n][k] = *(const LAS bf16x8*)(lds + PG8_SB(b, h) + boff + n * 2048 + k * 1024); } while (0)
#define PG8_MMA(ai, bj, At, Bt) do { __builtin_amdgcn_s_setprio(1); _Pragma("unroll") for (int m = 0; m < 4; ++m) _Pragma("unroll") for (int n = 0; n < 2; ++n) _Pragma("unroll") for (int k = 0; k < 2; ++k) \
        acc[ai][bj][m][n] = __builtin_amdgcn_mfma_f32_16x16x32_bf16(Bt[n][k], At[m][k], acc[ai][bj][m][n], 0, 0, 0); __builtin_amdgcn_s_setprio(0); } while (0)
#define PG8_WAIT_V(n) asm volatile("s_waitcnt vmcnt(" #n ")" ::: "memory")
#define PG8_WAIT_L(n) asm volatile("s_waitcnt lgkmcnt(" #n ")" ::: "memory")
#define PG8_BAR __builtin_amdgcn_s_barrier()
#define PG8_SCHED __builtin_amdgcn_sched_barrier(0)
    Unit cur, nxt; int ui = 0;
    if (!S.next(0, cur)) return;
    f32x4 acc[2][2][4][2];
#pragma unroll
    for (int a = 0; a < 2; ++a)
#pragma unroll
        for (int b = 0; b < 2; ++b)
#pragma unroll
            for (int m = 0; m < 4; ++m)
#pragma unroll
                for (int n = 0; n < 2; ++n) acc[a][b][m][n] = (f32x4){0.f, 0.f, 0.f, 0.f};
    bf16x8 At[4][2], B0[2][2], B1[2][2];
    const char* cA = (const char*)g.A + (size_t)cur.pm * tstepA + (size_t)cur.pn * g.kpn; const char* cB = (const char*)g.Bt + (size_t)cur.pn * tstepB + (size_t)cur.pn * g.kpn;
    PG8_STAGE(PG8_SB(0, 0), cB, voffB); PG8_STAGE(PG8_SB(0, 1), cB + hstepB, voffB); PG8_STAGE(PG8_SA(0, 0), cA, voffA); PG8_STAGE(PG8_SA(0, 1), cA + hstepA, voffA);
    if (wr == 1) PG8_BAR;
    PG8_WAIT_V(2); PG8_BAR;
    PG8_STAGE(PG8_SB(1, 0), cB + kstep, voffB); PG8_STAGE(PG8_SA(1, 0), cA + kstep, voffA); PG8_STAGE(PG8_SB(1, 1), cB + hstepB + kstep, voffB);
    PG8_WAIT_V(6); PG8_BAR;
    for (;;) {
        const bool has_next = S.next(ui + 1, nxt);
        const char* nA = has_next ? (const char*)g.A + (size_t)nxt.pm * tstepA + (size_t)nxt.pn * g.kpn : cA; const char* nB = has_next ? (const char*)g.Bt + (size_t)nxt.pn * tstepB + (size_t)nxt.pn * g.kpn : cB;
#pragma nounroll
        for (int t = 0; t < nt; t += 2) {
            const bool last = (t == nt - 2);
            const char* a1 = cA + (size_t)(t + 1) * kstep;
            const char* a2 = last ? nA : cA + (size_t)(t + 2) * kstep; const char* b2 = last ? nB : cB + (size_t)(t + 2) * kstep;
            const char* a3 = a2 + kstep; const char* b3 = b2 + kstep;
            PG8_LDB(B0, 0, 0); PG8_LDB(B1, 0, 1); PG8_SCHED; PG8_LDA(At, 0, 0); PG8_STAGE(PG8_SA(1, 1), a1 + hstepA, voffA);
            PG8_WAIT_V(8); PG8_WAIT_L(0); PG8_BAR; PG8_MMA(0, 0, At, B0); PG8_MMA(0, 1, At, B1); PG8_BAR; PG8_SCHED;
            PG8_LDA(At, 0, 1); PG8_STAGE(PG8_SB(0, 0), b2, voffB); PG8_STAGE(PG8_SB(0, 1), b2 + hstepB, voffB); PG8_STAGE(PG8_SA(0, 0), a2, voffA);
            PG8_WAIT_V(8); PG8_WAIT_L(0); PG8_BAR; PG8_MMA(1, 0, At, B0); PG8_MMA(1, 1, At, B1); PG8_BAR; PG8_SCHED;
            PG8_LDB(B0, 1, 0); PG8_LDB(B1, 1, 1); PG8_SCHED; PG8_LDA(At, 1, 0); PG8_STAGE(PG8_SA(0, 1), a2 + hstepA, voffA);
            PG8_WAIT_V(8); PG8_WAIT_L(0); PG8_BAR; PG8_MMA(0, 0, At, B0); PG8_MMA(0, 1, At, B1); PG8_BAR; PG8_SCHED;
            PG8_LDA(At, 1, 1); PG8_STAGE(PG8_SB(1, 0), b3, voffB); PG8_STAGE(PG8_SB(1, 1), b3 + hstepB, voffB); PG8_STAGE(PG8_SA(1, 0), a3, voffA);
            PG8_WAIT_V(8); PG8_WAIT_L(0); PG8_BAR; PG8_MMA(1, 0, At, B0); PG8_MMA(1, 1, At, B1); PG8_BAR; PG8_SCHED;
        }
        if constexpr (ALIGN_EPI) { if (wr == 0) PG8_BAR; }
        E(acc, cur, ui, wr, wc, fr, fq);
        if (!has_next) break;
#pragma unroll
        for (int a = 0; a < 2; ++a)
#pragma unroll
            for (int b = 0; b < 2; ++b)
#pragma unroll
                for (int m = 0; m < 4; ++m)
#pragma unroll
                    for (int n = 0; n < 2; ++n) acc[a][b][m][n] = (f32x4){0.f, 0.f, 0.f, 0.f};
        cur = nxt; cA = nA; cB = nB; ++ui;
        if constexpr (ALIGN_EPI) { if (wr == 1) PG8_BAR; }
    }
    PG8_WAIT_V(0);
    if constexpr (!ALIGN_EPI) { if (wr == 0) PG8_BAR; }
    PG8_BAR;
#undef PG8_SA
#undef PG8_SB
#undef PG8_STAGE
#undef PG8_LDA
#undef PG8_LDB
#undef PG8_MMA
#undef PG8_WAIT_V
#undef PG8_WAIT_L
#undef PG8_BAR
#undef PG8_SCHED
}

typedef f32x4 Acc[2][2][4][2];

__device__ __forceinline__ u32x4 pack8(const f32x4 v0, const f32x4 v1) { u32x4 w; w.x = cvt_pk_bf16(v0[0], v0[1]); w.y = cvt_pk_bf16(v0[2], v0[3]); w.z = cvt_pk_bf16(v1[0], v1[1]); w.w = cvt_pk_bf16(v1[2], v1[3]); return w; }
__device__ __forceinline__ void unpack8(const u32x4 w, f32x4& v0, f32x4& v1) { v0 = (f32x4){bflo(w.x), bfhi(w.x), bflo(w.y), bfhi(w.y)}; v1 = (f32x4){bflo(w.z), bfhi(w.z), bflo(w.w), bfhi(w.w)}; }

template <bool NORM> struct EpiSwiGLU {
    static constexpr bool PERM = true;
    bf16_t* O; int ldo; const LAS float* rstdL; const LAS float* swL;
    __device__ __forceinline__ void operator()(const Acc& acc, const Unit& u, int ui, int wr, int wc, int fr, int fq) const {
        const int col0 = u.pn * HALF + wc * 32 + 8 * fq;
        f32x4 sa[2], sb[2];
        if (NORM) { const LAS float* sp = swL + ui * 256 + wc * 32 + 8 * fq;
#pragma unroll
            for (int n = 0; n < 2; ++n) { sa[n] = *(const LAS f32x4*)(sp + 4 * n); sb[n] = *(const LAS f32x4*)(sp + HALF + 4 * n); } }
#pragma unroll
        for (int ai = 0; ai < 2; ++ai)
#pragma unroll
            for (int m = 0; m < 4; ++m) {
                const int rl = wr * 64 + fr + ai * HALF + m * 16, r = u.pm * BM + rl;
                float rstd = 1.0f;
                if (NORM) rstd = rstdL[ui * 256 + rl];
                f32x4 v[2];
#pragma unroll
                for (int n = 0; n < 2; ++n) { f32x4 a = acc[ai][0][m][n], b = acc[ai][1][m][n];
                    if (NORM) { a = a * rstd + sa[n]; b = b * rstd + sb[n]; }
                    v[n] = (a * b) * sigm4(a); }
                __builtin_amdgcn_raw_buffer_store_b128(pack8(v[0], v[1]), wt_rsrc(O, (unsigned)M * (unsigned)ldo * 2u), ((unsigned)r * (unsigned)ldo + (unsigned)col0) * 2u, 0, 16);
            }
    }
};
struct EpiGLU {
    static constexpr bool PERM = true;
    bf16_t* O; int ldo; const float* bias; int nhalf;
    __device__ __forceinline__ void operator()(const Acc& acc, const Unit& u, int ui, int wr, int wc, int fr, int fq) const {
        const int row0 = u.pm * BM + wr * 64 + fr, col0 = u.pn * HALF + wc * 32 + 8 * fq;
        f32x4 bv[2], bg[2];
#pragma unroll
        for (int n = 0; n < 2; ++n) { bv[n] = *(const f32x4*)(bias + col0 + 4 * n); bg[n] = *(const f32x4*)(bias + nhalf + col0 + 4 * n); }
#pragma unroll
        for (int ai = 0; ai < 2; ++ai)
#pragma unroll
            for (int m = 0; m < 4; ++m) {
                f32x4 v[2];
#pragma unroll
                for (int n = 0; n < 2; ++n) { const f32x4 a = acc[ai][0][m][n] + bv[n], b = acc[ai][1][m][n] + bg[n];
                    v[n] = a * sigm4(b); }
                *(u32x4*)(O + (size_t)(row0 + ai * HALF + m * 16) * ldo + col0) = pack8(v[0], v[1]);
            }
    }
};
template <bool NEXT, bool HALFS> struct EpiResid {
    static constexpr bool PERM = false;
    static constexpr float s = HALFS ? 0.5f : 1.0f;
    const float* base; float* out; const float* gate0;
    bf16_t* xg; const float* gnext; const float* scale0; float* rss;
    __device__ __forceinline__ void operator()(const Acc& acc, const Unit& u, int ui, int wr, int wc, int fr, int fq) const {
        const int row0 = u.pm * BM + wr * 64 + fr, col0 = u.pn * BM + wc * 32 + 4 * fq;
        const float* gate = gate0 + (size_t)(u.pm >> 4) * NMODC;
        const char* bp = (const char*)base; char* op = (char*)out; char* xp = (char*)xg;
        unsigned rb[2][4];
        float ss[2][4];
#pragma unroll
        for (int ai = 0; ai < 2; ++ai)
#pragma unroll
            for (int m = 0; m < 4; ++m) { ss[ai][m] = 0.f; rb[ai][m] = (unsigned)((row0 + ai * HALF + m * 16) * D + col0) * 4u; }
#pragma unroll
        for (int bj = 0; bj < 2; ++bj)
#pragma unroll
            for (int n = 0; n < 2; ++n) {
                const int c = col0 + bj * HALF + n * 16; const unsigned cb = (unsigned)(bj * HALF + n * 16) * 4u;
                f32x4 bs[2][4];
#pragma unroll
                for (int ai = 0; ai < 2; ++ai)
#pragma unroll
                    for (int m = 0; m < 4; ++m) bs[ai][m] = *(const f32x4*)(bp + (rb[ai][m] + cb));
                const f32x4 gv = *(const f32x4*)(gate + c) * s;
                f32x4 gsv = gv;
                if (NEXT) gsv = *(const f32x4*)(gnext + c) * (*(const f32x4*)(scale0 + (size_t)(u.pm >> 4) * NMODC + c) + 1.0f);
#pragma unroll
                for (int ai = 0; ai < 2; ++ai)
#pragma unroll
                    for (int m = 0; m < 4; ++m) {
                        const f32x4 xn = bs[ai][m] + gv * acc[ai][bj][m][n];
                        *(f32x4*)(op + (rb[ai][m] + cb)) = xn;
                        if (NEXT) { ss[ai][m] += (xn.x * xn.x + xn.y * xn.y) + (xn.z * xn.z + xn.w * xn.w); const f32x4 o = xn * gsv; u32x2 w; w.x = cvt_pk_bf16(o.x, o.y); w.y = cvt_pk_bf16(o.z, o.w);
                            *(u32x2*)(xp + ((rb[ai][m] + cb) >> 1)) = w; } }
            }
        if (NEXT) {
#pragma unroll
            for (int ai = 0; ai < 2; ++ai)
#pragma unroll
                for (int m = 0; m < 4; ++m) { float t = ss[ai][m]; t += __shfl_xor(t, 16); t += __shfl_xor(t, 32); if (fq == 0) rss[(size_t)(row0 + ai * HALF + m * 16) * 16 + u.pn * 4 + wc] = t; }
        }
    }
};
struct EpiWin {
    static constexpr bool PERM = true;
    bf16_t *upool, *assm, *sigp, *sigs; const LAS float* rstdL; const LAS float* swL;
    __device__ __forceinline__ void operator()(const Acc& acc, const Unit& u, int ui, int wr, int wc, int fr, int fq) const {
        const int pn = u.pn;
        f32x4 sv[2][2];
        { const LAS float* sp = swL + ui * 256 + wc * 32 + 8 * fq;
#pragma unroll
          for (int bj = 0; bj < 2; ++bj)
#pragma unroll
              for (int n = 0; n < 2; ++n) sv[bj][n] = *(const LAS f32x4*)(sp + bj * HALF + 4 * n); }
#pragma unroll
        for (int ai = 0; ai < 2; ++ai)
#pragma unroll
            for (int m = 0; m < 4; ++m) { const int rl = wr * 64 + fr + ai * HALF + m * 16, r = u.pm * BM + rl;
                const float rstd = rstdL[ui * 256 + rl];
#pragma unroll
                for (int bj = 0; bj < 2; ++bj) {
                    f32x4 v0 = acc[ai][bj][m][0] * rstd + sv[bj][0], v1 = acc[ai][bj][m][1] * rstd + sv[bj][1];
                    const int cl = bj * HALF + wc * 32 + 8 * fq;
                    if (pn < 2) { *(u32x4*)(upool + (size_t)r * PWID + pn * BM + cl) = pack8(v0, v1); }
                    else if (pn < 4) { const int cs = (pn - 2) * BM + cl, g = cs >> 4, h0 = cs & 15;
                        *(u32x4*)(assm + ((size_t)(g * RPG + (r >> 5)) * KA + (r & 31) * GH + h0)) = pack8(v0, v1); }
                    else {
                        v0 = sigm4(v0); v1 = sigm4(v1);
                        bf16_t* dst = (pn < 8) ? (sigp + (size_t)r * D + (pn - 4) * BM + cl) : (sigs + (size_t)r * D + (pn - 8) * BM + cl);
                        *(u32x4*)dst = pack8(v0, v1); }
                } }
    }
};
struct EpiPool1 {
    static constexpr bool PERM = true;
    bf16_t* O; const float* pb; const float* ps;
    __device__ __forceinline__ void operator()(const Acc& acc, const Unit& u, int ui, int wr, int wc, int fr, int fq) const {
        const int row0 = u.pm * BM + wr * 64 + fr, col0 = u.pn * BM + wc * 32 + 8 * fq;
        f32x4 b[2][2], s[2][2];
#pragma unroll
        for (int bj = 0; bj < 2; ++bj)
#pragma unroll
            for (int n = 0; n < 2; ++n) { b[bj][n] = *(const f32x4*)(pb + col0 + bj * HALF + 4 * n); s[bj][n] = *(const f32x4*)(ps + col0 + bj * HALF + 4 * n); }
#pragma unroll
        for (int ai = 0; ai < 2; ++ai)
#pragma unroll
            for (int m = 0; m < 4; ++m) { bf16_t* rowp = O + (size_t)(row0 + ai * HALF + m * 16) * PWID + col0;
#pragma unroll
                for (int bj = 0; bj < 2; ++bj) *(u32x4*)(rowp + bj * HALF) = pack8((acc[ai][bj][m][0] + b[bj][0]) * s[bj][0], (acc[ai][bj][m][1] + b[bj][1]) * s[bj][1]); }
    }
};
template <bool ADD> struct EpiGateAcc {
    static constexpr bool PERM = true;
    bf16_t* O; const bf16_t* sig;
    __device__ __forceinline__ void operator()(const Acc& acc, const Unit& u, int ui, int wr, int wc, int fr, int fq) const {
        const int row0 = u.pm * BM + wr * 64 + fr, col0 = u.pn * BM + wc * 32 + 8 * fq;
#pragma unroll
        for (int ai = 0; ai < 2; ++ai) {
            u32x4 sg[4][2], pv[4][2];
#pragma unroll
            for (int m = 0; m < 4; ++m)
#pragma unroll
                for (int bj = 0; bj < 2; ++bj) { const size_t off = (size_t)(row0 + ai * HALF + m * 16) * D + col0 + bj * HALF; sg[m][bj] = *(const u32x4*)(sig + off); if (ADD) pv[m][bj] = *(const u32x4*)(O + off); }
#pragma unroll
            for (int m = 0; m < 4; ++m) { const size_t off = (size_t)(row0 + ai * HALF + m * 16) * D + col0;
#pragma unroll
                for (int bj = 0; bj < 2; ++bj) { f32x4 s0, s1; unpack8(sg[m][bj], s0, s1);
                    f32x4 v0 = s0 * acc[ai][bj][m][0], v1 = s1 * acc[ai][bj][m][1];
                    if (ADD) { f32x4 p0, p1; unpack8(pv[m][bj], p0, p1); v0 += p0; v1 += p1; }
                    *(u32x4*)(O + off + bj * HALF) = pack8(v0, v1); } }
        }
    }
};
struct EpiPlain {
    static constexpr bool PERM = true;
    bf16_t* O; int ldo;
    __device__ __forceinline__ void operator()(const Acc& acc, const Unit& u, int ui, int wr, int wc, int fr, int fq) const {
        const int row0 = u.pm * BM + wr * 64 + fr, col0 = u.pn * BM + wc * 32 + 8 * fq;
#pragma unroll
        for (int ai = 0; ai < 2; ++ai)
#pragma unroll
            for (int m = 0; m < 4; ++m) { bf16_t* rowp = O + (size_t)(row0 + ai * HALF + m * 16) * ldo + col0;
#pragma unroll
                for (int bj = 0; bj < 2; ++bj) __builtin_amdgcn_raw_buffer_store_b128(pack8(acc[ai][bj][m][0], acc[ai][bj][m][1]), wt_rsrc(O, (unsigned)M * (unsigned)ldo * 2u), (unsigned)((rowp + bj * HALF) - O) * 2u, 0, 16); }
    }
};
struct EpiE {
    static constexpr bool PERM = false;
    float* E;
    __device__ __forceinline__ void operator()(const Acc& acc, const Unit& u, int ui, int wr, int wc, int fr, int fq) const {
        const int row0 = u.pm * BM + wr * 64 + fr, col0 = wc * 32 + 4 * fq;
#pragma unroll
        for (int ai = 0; ai < 2; ++ai)
#pragma unroll
            for (int m = 0; m < 4; ++m) { float* rowp = E + (size_t)(row0 + ai * HALF + m * 16) * 128 + col0;
#pragma unroll
                for (int n = 0; n < 2; ++n) *(f32x4*)(rowp + n * 16) = acc[ai][0][m][n]; }
    }
};
struct EpiY {
    static constexpr bool PERM = true;
    bf16_t* yg; const bf16_t* assm; const float* dskip;
    __device__ __forceinline__ void operator()(const Acc& acc, const Unit& u, int ui, int wr, int wc, int fr, int fq) const {
        const int g = u.pm >> 2, pnl = u.pn & 1;
        const int arow0 = u.pm * BM + wr * 64 + fr;
#pragma unroll
        for (int bj = 0; bj < 2; ++bj) {
            const int nloc = pnl * BM + bj * HALF + wc * 32 + 8 * fq, tl = nloc >> 4, h0 = nloc & 15;
            const f32x4 d0 = *(const f32x4*)(dskip + g * GH + h0), d1 = *(const f32x4*)(dskip + g * GH + h0 + 4);
            u32x4 uu[2][4];
#pragma unroll
            for (int ai = 0; ai < 2; ++ai)
#pragma unroll
                for (int m = 0; m < 4; ++m) uu[ai][m] = *(const u32x4*)(assm + (size_t)(arow0 + ai * HALF + m * 16) * KA + nloc);
#pragma unroll
            for (int ai = 0; ai < 2; ++ai)
#pragma unroll
                for (int m = 0; m < 4; ++m) { const int arow = arow0 + ai * HALF + m * 16, rl = arow - g * RPG;
                    f32x4 u0, u1; unpack8(uu[ai][m], u0, u1);
                    f32x4 v0 = acc[ai][bj][m][0] + d0 * u0, v1 = acc[ai][bj][m][1] + d1 * u1;
                    { const f32x2 g0 = gelu_pk((f32x2){v0[0], v0[1]}), g1 = gelu_pk((f32x2){v0[2], v0[3]}), g2 = gelu_pk((f32x2){v1[0], v1[1]}), g3 = gelu_pk((f32x2){v1[2], v1[3]});
                      v0 = (f32x4){g0.x, g0.y, g1.x, g1.y}; v1 = (f32x4){g2.x, g2.y, g3.x, g3.y}; }
                    *(u32x4*)(yg + (size_t)(rl * CL + tl) * SWID + g * GH + h0) = pack8(v0, v1); }
        }
    }
};
}

#define XB_TMO      128
#define XB_XCNT(j)  (256  + 64 * (j))
#define XB_XSUB(j)  (1280 + 64 * (j))
#define XB_XGEN(j)  (2304 + 64 * (j))
#define XB_TOP      3328
#define XB_TOPGEN   3392
#define XCD_BAR_WORDS 3456
#define XB_SPIN_CAP (1u << 22)
__device__ __forceinline__ unsigned xb_ld(unsigned* p)              { return __hip_atomic_load(p, __ATOMIC_RELAXED, __HIP_MEMORY_SCOPE_AGENT); }
__device__ __forceinline__ unsigned xb_add(unsigned* p, unsigned v) { return __hip_atomic_fetch_add(p, v, __ATOMIC_RELAXED, __HIP_MEMORY_SCOPE_AGENT); }
__device__ __forceinline__ unsigned xb_xcc_id() { return (unsigned)__builtin_amdgcn_s_getreg((3 << 11) | 20) & 0xFu; }
#define XB_SPIN(cond, bar) do { unsigned _sp = 0; while (cond) { __builtin_amdgcn_s_sleep(1); \
    if ((++_sp & 255u) == 0u) { if (xb_ld(&(bar)[XB_TMO])) break; if (_sp > XB_SPIN_CAP) { atomicAdd(&(bar)[XB_TMO], 1u); break; } } } } while (0)
struct XcdBarrier { unsigned* bar; unsigned x; volatile LAS unsigned* st; };
__device__ __forceinline__ XcdBarrier xcd_barrier_post(unsigned* bar, volatile LAS unsigned* st) {
    XcdBarrier b; b.bar = bar; b.x = xb_xcc_id(); b.st = st;
    if (threadIdx.x == 0) (void)xb_add(&bar[XB_XCNT(b.x)], 1u);
    return b;
}
__device__ __forceinline__ void xcd_barrier_complete(unsigned* bar, unsigned x, unsigned& nloc, unsigned& nx) {
    const unsigned G = gridDim.x * gridDim.y * gridDim.z;
    unsigned sum, cnt, mine, sp = 0u;
    for (;;) {
        sum = 0u; cnt = 0u; mine = 0u;
#pragma unroll
        for (unsigned j = 0; j < 16; ++j) { const unsigned c = xb_ld(&bar[XB_XCNT(j)]); sum += c; cnt += (c > 0u) ? 1u : 0u; mine = (j == x) ? c : mine; }
        if (sum == G) break;
        __builtin_amdgcn_s_sleep(1);
        if ((++sp & 255u) == 0u) { if (xb_ld(&bar[XB_TMO])) break; if (sp > XB_SPIN_CAP) { atomicAdd(&bar[XB_TMO], 1u); break; } }
    }
    nloc = mine > 0u ? mine : 1u; nx = cnt > 0u ? cnt : 1u;
}
__device__ __forceinline__ void xcd_barrier(const XcdBarrier& b) {
    asm volatile("s_waitcnt vmcnt(0)" ::: "memory");
    __syncthreads();
    if (threadIdx.x == 0) {
        unsigned* bar = b.bar;
        __builtin_amdgcn_s_waitcnt(0);
        unsigned nloc = b.st[0], nx = b.st[1];
        if (nloc == 0u) { xcd_barrier_complete(bar, b.x, nloc, nx); b.st[0] = nloc; b.st[1] = nx; }
        const unsigned old = xb_add(&bar[XB_XSUB(b.x)], 1u);
        const unsigned gen = old / nloc;
        if (old + 1u == (gen + 1u) * nloc) {
            __builtin_amdgcn_fence(__ATOMIC_RELEASE, "agent");
            asm volatile("s_waitcnt vmcnt(0)" ::: "memory");
            const unsigned og = xb_add(&bar[XB_TOP], 1u);
            const unsigned tg = og / nx;
            if (og + 1u == (tg + 1u) * nx) xb_add(&bar[XB_TOPGEN], 1u);
            else XB_SPIN(xb_ld(&bar[XB_TOPGEN]) == tg, bar);
            __builtin_amdgcn_fence(__ATOMIC_ACQUIRE, "agent");
            xb_add(&bar[XB_XGEN(b.x)], 1u);
            asm volatile("s_waitcnt vmcnt(0)" ::: "memory");
        } else {
            XB_SPIN(xb_ld(&bar[XB_XGEN(b.x)]) == gen, bar);
            __builtin_amdgcn_fence(__ATOMIC_ACQUIRE, "agent");
            asm volatile("s_waitcnt vmcnt(0)" ::: "memory");
        }
    }
    __syncthreads();
}

struct Args { const float* in[29]; float* out; unsigned char* ws; };

__device__ __forceinline__ void transpose_block(const float* __restrict__ W, int N, bf16_t* WT, int ldo, int k0, int n0, int orow0, LAS float* scr, int lane) {
    float t[32];
    const float* Wk = W + (size_t)k0 * N + n0;
    const unsigned lo = (unsigned)((lane >> 5) * N + (lane & 31));
#pragma unroll
    for (int i = 0; i < 32; ++i) t[i] = __builtin_nontemporal_load((Wk + (size_t)(2 * i) * N) + lo);
#pragma unroll
    for (int i = 0; i < 32; ++i) { const int kk = 2 * i + (lane >> 5); scr[kk * 33 + (lane & 31)] = t[i]; }
    LDS_WAIT();
    const int c = lane & 7;
#pragma unroll
    for (int j = 0; j < 4; ++j) { const int n = (lane >> 3) + 8 * j; const LAS float* s = scr + (8 * c) * 33 + n;
        u32x4 o; o.x = cvt_pk_bf16(s[0 * 33], s[1 * 33]); o.y = cvt_pk_bf16(s[2 * 33], s[3 * 33]); o.z = cvt_pk_bf16(s[4 * 33], s[5 * 33]); o.w = cvt_pk_bf16(s[6 * 33], s[7 * 33]);
        *(u32x4*)(WT + (size_t)(orow0 + n) * ldo + k0 + 8 * c) = o; }
    LDS_WAIT();
}
__device__ __forceinline__ void transpose_item(const float* W, int K, int N, bf16_t* WT, int nhalf, int item, LAS float* scr, int lane) {
    const int nblk = N / 32, kb = item / nblk, nb = item % nblk, k0 = 64 * kb, n0 = 32 * nb;
    int orow0 = n0;
    if (nhalf > 0) { const int h = n0 / nhalf, j = n0 % nhalf; orow0 = 256 * (j / 128) + 128 * h + (j % 128); }
    transpose_block(W, N, WT, K, k0, n0, orow0, scr, lane);
}

__device__ __forceinline__ void ssm_prep_stage1(const Args& a, int g, int sub, LAS float* L, int tid) {
    LAS float* PWR = L; LAS float* PWI = L + 2112; LAS float* BBR = L + 4224; LAS float* BBI = L + 5248; LAS float* CR = L + 6272; LAS float* CI = L + 7296;
    const float* lam_re_log = a.in[13]; const float* lam_im = a.in[14]; const float* log_dt = a.in[15];
    const float* b_re = a.in[16]; const float* b_im = a.in[17]; const float* c_re = a.in[18]; const float* c_im = a.in[19];
    bf16_t* BtY = (bf16_t*)(a.ws + WS_BTY); bf16_t* BtE = (bf16_t*)(a.ws + WS_BTE); float* A32 = (float*)(a.ws + WS_A32); float* KTg = (float*)(a.ws + WS_KT);
    if (tid < 64) {
        const int n = tid;
        const float lr = -expf(lam_re_log[g * NS + n]), li = lam_im[g * NS + n], dt = expf(log_dt[g]);
        const float mag = expf(lr * dt), ang = li * dt;
        const float abr = mag * cosf(ang), abi = mag * sinf(ang);
        const float nr = abr - 1.0f, ni = abi, den = lr * lr + li * li;
        const float fr = (nr * lr + ni * li) / den, fi = (ni * lr - nr * li) / den;
        float pr = 1.0f, pi = 0.0f;
        for (int tau = 0; tau <= CL; ++tau) { PWR[tau * NS + n] = pr; PWI[tau * NS + n] = pi; const float q = pr * abr - pi * abi; pi = pr * abi + pi * abr; pr = q; }
        if (sub == 0) { A32[(g * NS + n) * 2] = PWR[CL * NS + n]; A32[(g * NS + n) * 2 + 1] = PWI[CL * NS + n]; }
        for (int hp = 0; hp < GH; ++hp) { const float br = b_re[(g * NS + n) * GH + hp], bi = b_im[(g * NS + n) * GH + hp];
            BBR[n * GH + hp] = fr * br - fi * bi; BBI[n * GH + hp] = fr * bi + fi * br; }
    }
    for (int e = tid; e < GH * NS; e += 512) { CR[e] = c_re[g * GH * NS + e]; CI[e] = c_im[g * GH * NS + e]; }
    __syncthreads();
    for (int e = tid; e < 4 * GH * GH; e += 512) { const int tau = 4 * sub + (e >> 8), h = (e >> 4) & 15, hp = e & 15; float s = 0.f;
        for (int n = 0; n < NS; ++n) { const float pr = PWR[tau * NS + n], pi = PWI[tau * NS + n], br = BBR[n * GH + hp], bi = BBI[n * GH + hp];
            const float Pr = pr * br - pi * bi, Pi = pr * bi + pi * br; s += CR[h * NS + n] * Pr - CI[h * NS + n] * Pi; }
        KTg[(size_t)g * (CL * 256) + tau * 256 + (e & 255)] = s; }
    for (int q = tid; q < 64 * 16; q += 512) { const int row = 64 * sub + (q >> 4), ch = q & 15, t = row >> 4, h = row & 15, isim = ch >> 3, n0 = (ch & 7) * 8;
        float v[8];
#pragma unroll
        for (int j = 0; j < 8; ++j) { const int n = n0 + j; const float cr = CR[h * NS + n], ci = CI[h * NS + n], pr = PWR[(t + 1) * NS + n], pi = PWI[(t + 1) * NS + n];
            v[j] = isim ? -(cr * pi + ci * pr) : (cr * pr - ci * pi); }
        u32x4 o; o.x = cvt_pk_bf16(v[0], v[1]); o.y = cvt_pk_bf16(v[2], v[3]); o.z = cvt_pk_bf16(v[4], v[5]); o.w = cvt_pk_bf16(v[6], v[7]);
        *(u32x4*)(BtY + ((size_t)(g * 512 + row) * KA + 512 + isim * 64 + n0)) = o; }
    for (int q = tid; q < 32 * 64; q += 512) { const int row = 32 * sub + (q >> 6), ch = q & 63, s = ch >> 1, hp0 = (ch & 1) * 8;
        u32x4 o = (u32x4){0u, 0u, 0u, 0u};
        if (row < 128) { const int n = row & 63, isim = row >> 6; const float pr = PWR[(CL - 1 - s) * NS + n], pi = PWI[(CL - 1 - s) * NS + n];
            float v[8];
#pragma unroll
            for (int j = 0; j < 8; ++j) { const float br = BBR[n * GH + hp0 + j], bi = BBI[n * GH + hp0 + j]; v[j] = isim ? (pr * bi + pi * br) : (pr * br - pi * bi); }
            o.x = cvt_pk_bf16(v[0], v[1]); o.y = cvt_pk_bf16(v[2], v[3]); o.z = cvt_pk_bf16(v[4], v[5]); o.w = cvt_pk_bf16(v[6], v[7]); }
        *(u32x4*)(BtE + ((size_t)(g * 256 + row) * 512 + s * GH + hp0)) = o; }
    __syncthreads();
}

template <bool HASD, bool WRX, bool FINAL, bool XOUTB = false>
__device__ __forceinline__ void row_pass(const float* Xin, const bf16_t* delta, const float* gate0, float s, float* Xout, const float* gvec, const float* mod, int sub, bf16_t* Hout, int gw, int ngw, int lane) {
    for (int blk = gw; blk < M / 16; blk += ngw) {
        const int r0 = blk * 16, b = r0 / SEQ;
        f32x4 gs[4], sh[4], gt[4];
#pragma unroll
        for (int j = 0; j < 4; ++j) { const int c = 4 * lane + 256 * j; const f32x4 gg = *(const f32x4*)(gvec + c);
            if (FINAL) { gs[j] = gg; sh[j] = (f32x4){0.f, 0.f, 0.f, 0.f}; }
            else { const float* shift = mod + (size_t)b * NMODC + (sub * 3 + 0) * D; gs[j] = gg * (*(const f32x4*)(shift + D + c) + 1.0f); sh[j] = *(const f32x4*)(shift + c); }
            if (HASD) gt[j] = *(const f32x4*)(gate0 + (size_t)b * NMODC + c) * s; }
        f32x4 v[4], nx[4], nx2[4]; u32x2 dl[4], nd[4], nd2[4];
        { const f32x4* xr = (const f32x4*)(Xin + (size_t)r0 * D) + lane; const u32x2* dr = (const u32x2*)(delta + (size_t)r0 * D) + lane;
#pragma unroll
          for (int j = 0; j < 4; ++j) { v[j] = __builtin_nontemporal_load(xr + 64 * j); if (HASD) dl[j] = __builtin_nontemporal_load(dr + 64 * j); }
#pragma unroll
          for (int j = 0; j < 4; ++j) { nx[j] = __builtin_nontemporal_load(xr + 64 * j + D / 4); if (HASD) nd[j] = __builtin_nontemporal_load(dr + 64 * j + D / 4); } }
        for (int r = r0; r < r0 + 16; ++r) {
            if (r + 2 < r0 + 16) { const f32x4* xr = (const f32x4*)(Xin + (size_t)(r + 2) * D) + lane; const u32x2* dr = (const u32x2*)(delta + (size_t)(r + 2) * D) + lane;
#pragma unroll
                for (int j = 0; j < 4; ++j) { nx2[j] = __builtin_nontemporal_load(xr + 64 * j); if (HASD) nd2[j] = __builtin_nontemporal_load(dr + 64 * j); } }
            float ss = 0.f;
#pragma unroll
            for (int j = 0; j < 4; ++j) {
                if (HASD) { const f32x4 d = (f32x4){bflo(dl[j].x), bfhi(dl[j].x), bflo(dl[j].y), bfhi(dl[j].y)}; v[j] += gt[j] * d; }
                ss += (v[j].x * v[j].x + v[j].y * v[j].y) + (v[j].z * v[j].z + v[j].w * v[j].w); }
            const float rstd = 1.0f / sqrtf(wave_sum(ss) * (1.0f / D) + EPS);
            if (FINAL) {
#pragma unroll
                for (int j = 0; j < 4; ++j) wt_store16<18>(v[j] * rstd * gs[j], wt_rsrc(Xout, (unsigned)M * D * 4u), (unsigned)r * (D * 4u) + (unsigned)lane * 16u + j * 1024u); }
            else {
                if (WRX && !XOUTB) {
#pragma unroll
                    for (int j = 0; j < 4; ++j) wt_store16<18>(v[j], wt_rsrc(Xout, (unsigned)M * D * 4u), (unsigned)r * (D * 4u) + (unsigned)lane * 16u + j * 1024u); }
                if (WRX && XOUTB) {
#pragma unroll
                    for (int j = 0; j < 4; ++j) { u32x2 w; w.x = cvt_pk_bf16(v[j].x, v[j].y); w.y = cvt_pk_bf16(v[j].z, v[j].w); wt_store8<18>(w, wt_rsrc(Xout, (unsigned)M * D * 2u), (unsigned)r * (D * 2u) + (unsigned)lane * 8u + j * 512u); } }
#pragma unroll
                for (int j = 0; j < 4; ++j) { const f32x4 o = v[j] * rstd * gs[j] + sh[j]; u32x2 w; w.x = cvt_pk_bf16(o.x, o.y); w.y = cvt_pk_bf16(o.z, o.w); wt_store8<16>(w, wt_rsrc(Hout, (unsigned)M * D * 2u), (unsigned)r * (D * 2u) + (unsigned)lane * 8u + j * 512u); } }
#pragma unroll
            for (int j = 0; j < 4; ++j) { v[j] = nx[j]; nx[j] = nx2[j]; if (HASD) { dl[j] = nd[j]; nd[j] = nd2[j]; } }
        }
    }
}

__device__ __forceinline__ void norm_mod_phase(const float* X, const float* gvec, const float* mod, int sub, bf16_t* Hout, int gw, int ngw, int lane) {
    for (int blk = gw; blk < M / 16; blk += ngw) {
        const int r0 = blk * 16, b = r0 / SEQ;
        const float* shift = mod + (size_t)b * NMODC + (sub * 3 + 0) * D; const float* scale = shift + D;
        f32x4 gs[4], sh[4];
#pragma unroll
        for (int j = 0; j < 4; ++j) { const int c = 4 * lane + 256 * j; const f32x4 gg = *(const f32x4*)(gvec + c), sc = *(const f32x4*)(scale + c); gs[j] = gg * (sc + 1.0f); sh[j] = *(const f32x4*)(shift + c); }
        f32x4 v[4], nx[4];
        { const f32x4* xr = (const f32x4*)(X + (size_t)r0 * D) + lane;
#pragma unroll
          for (int j = 0; j < 4; ++j) v[j] = xr[64 * j]; }
        for (int r = r0; r < r0 + 16; ++r) {
            if (r + 1 < r0 + 16) { const f32x4* xr = (const f32x4*)(X + (size_t)(r + 1) * D) + lane;
#pragma unroll
                for (int j = 0; j < 4; ++j) nx[j] = xr[64 * j]; }
            float s = 0.f;
#pragma unroll
            for (int j = 0; j < 4; ++j) s += (v[j].x * v[j].x + v[j].y * v[j].y) + (v[j].z * v[j].z + v[j].w * v[j].w);
            const float rstd = 1.0f / sqrtf(wave_sum(s) * (1.0f / D) + EPS);
            u32x2* o8 = (u32x2*)(Hout + (size_t)r * D) + lane;
#pragma unroll
            for (int j = 0; j < 4; ++j) { const f32x4 o = v[j] * rstd * gs[j] + sh[j]; u32x2 w; w.x = cvt_pk_bf16(o.x, o.y); w.y = cvt_pk_bf16(o.z, o.w); o8[64 * j] = w; }
#pragma unroll
            for (int j = 0; j < 4; ++j) v[j] = nx[j];
        }
    }
}

__device__ __forceinline__ void resid_xg_pass(const float* Xin, const bf16_t* delta, const float* gate0, float s, float* Xout, const float* gvec, const float* mod, int sub, bf16_t* Hout, float* rss, int gw, int ngw, int lane) {
    for (int blk = gw; blk < M / 16; blk += ngw) {
        const int r0 = blk * 16, b = r0 / SEQ;
        f32x4 gs[4], gt[4];
#pragma unroll
        for (int j = 0; j < 4; ++j) { const int c = 4 * lane + 256 * j; const float* shift = mod + (size_t)b * NMODC + (sub * 3 + 0) * D;
            gs[j] = *(const f32x4*)(gvec + c) * (*(const f32x4*)(shift + D + c) + 1.0f); gt[j] = *(const f32x4*)(gate0 + (size_t)b * NMODC + c) * s; }
        f32x4 v[4], nx[4], nx2[4]; u32x2 dl[4], nd[4], nd2[4];
        { const f32x4* xr = (const f32x4*)(Xin + (size_t)r0 * D) + lane; const u32x2* dr = (const u32x2*)(delta + (size_t)r0 * D) + lane;
#pragma unroll
          for (int j = 0; j < 4; ++j) { v[j] = __builtin_nontemporal_load(xr + 64 * j); dl[j] = __builtin_nontemporal_load(dr + 64 * j); }
#pragma unroll
          for (int j = 0; j < 4; ++j) { nx[j] = __builtin_nontemporal_load(xr + 64 * j + D / 4); nd[j] = __builtin_nontemporal_load(dr + 64 * j + D / 4); } }
        for (int r = r0; r < r0 + 16; ++r) {
            if (r + 2 < r0 + 16) { const f32x4* xr = (const f32x4*)(Xin + (size_t)(r + 2) * D) + lane; const u32x2* dr = (const u32x2*)(delta + (size_t)(r + 2) * D) + lane;
#pragma unroll
                for (int j = 0; j < 4; ++j) { nx2[j] = __builtin_nontemporal_load(xr + 64 * j); nd2[j] = __builtin_nontemporal_load(dr + 64 * j); } }
            float ss = 0.f;
#pragma unroll
            for (int j = 0; j < 4; ++j) { const f32x4 d = (f32x4){bflo(dl[j].x), bfhi(dl[j].x), bflo(dl[j].y), bfhi(dl[j].y)}; v[j] += gt[j] * d;
                ss += (v[j].x * v[j].x + v[j].y * v[j].y) + (v[j].z * v[j].z + v[j].w * v[j].w); }
            ss = wave_sum(ss);
            if (lane < 16) rss[(size_t)r * 16 + lane] = (lane == 0) ? ss : 0.f;
#pragma unroll
            for (int j = 0; j < 4; ++j) { wt_store16<18>(v[j], wt_rsrc(Xout, (unsigned)M * D * 4u), (unsigned)r * (D * 4u) + (unsigned)lane * 16u + j * 1024u);
                const f32x4 o = v[j] * gs[j]; u32x2 w; w.x = cvt_pk_bf16(o.x, o.y); w.y = cvt_pk_bf16(o.z, o.w); wt_store8<16>(w, wt_rsrc(Hout, (unsigned)M * D * 2u), (unsigned)r * (D * 2u) + (unsigned)lane * 8u + j * 512u); }
#pragma unroll
            for (int j = 0; j < 4; ++j) { v[j] = nx[j]; nx[j] = nx2[j]; dl[j] = nd[j]; nd[j] = nd2[j]; }
        }
    }
}

template <int W> __device__ __forceinline__ void zpass_group(const bf16_t* UP, bf16_t* Z, int tb, int k, int lane) {
    const int cl = lane & 15, tq = lane >> 4;
    const int t0 = tb * 16 + tq * 4, tin = t0 & (SEQ - 1), c0 = k * 128 + cl * 8;
    constexpr int NR = W + 3;
    u32x4 rows[NR];
#pragma unroll
    for (int j = 0; j < NR; ++j) { const int dt = j - (W - 1);
        rows[j] = (tin + dt >= 0) ? *(const u32x4*)(UP + (size_t)(t0 + dt) * PWID + c0) : (u32x4){0u, 0u, 0u, 0u}; }
    f32x4 s0 = (f32x4){0.f, 0.f, 0.f, 0.f}, s1 = s0;
#pragma unroll
    for (int j = 0; j < W; ++j) { f32x4 a0, a1; pg8::unpack8(rows[j], a0, a1); s0 += a0; s1 += a1; }
#pragma unroll
    for (int i = 0; i < 4; ++i) {
        f32x4 c0v, c1v; pg8::unpack8(rows[W - 1 + i], c0v, c1v);
        if (i > 0) { f32x4 o0, o1; pg8::unpack8(rows[i - 1], o0, o1); s0 += c0v - o0; s1 += c1v - o1; }
        const int cnt = (tin + i + 1 < W) ? (tin + i + 1) : W; const float inv = 1.0f / (float)cnt;
        *(u32x4*)(Z + (size_t)(t0 + i) * PWID + c0) = pg8::pack8(s0 * inv - c0v, s1 * inv - c1v);
    }
}

__device__ __forceinline__ void final_pass_bf16x(const bf16_t* Xb, const bf16_t* delta, const float* gate0, float s, float* out, const float* gvec, int blk, int lane) {
    const int r0 = blk * 16, b = r0 / SEQ;
    f32x4 gs[4], gt[4];
#pragma unroll
    for (int j = 0; j < 4; ++j) { const int c = 4 * lane + 256 * j; gs[j] = *(const f32x4*)(gvec + c); gt[j] = *(const f32x4*)(gate0 + (size_t)b * NMODC + c) * s; }
    u32x2 xa[4], xn1[4], xn2[4], da[4], dn1[4], dn2[4];
    { const u32x2* xr = (const u32x2*)(Xb + (size_t)r0 * D) + lane; const u32x2* dr = (const u32x2*)(delta + (size_t)r0 * D) + lane;
#pragma unroll
      for (int j = 0; j < 4; ++j) { xa[j] = __builtin_nontemporal_load(xr + 64 * j); da[j] = __builtin_nontemporal_load(dr + 64 * j); }
#pragma unroll
      for (int j = 0; j < 4; ++j) { xn1[j] = __builtin_nontemporal_load(xr + 64 * j + D / 4); dn1[j] = __builtin_nontemporal_load(dr + 64 * j + D / 4); } }
    for (int r = r0; r < r0 + 16; ++r) {
        if (r + 2 < r0 + 16) { const u32x2* xr = (const u32x2*)(Xb + (size_t)(r + 2) * D) + lane; const u32x2* dr = (const u32x2*)(delta + (size_t)(r + 2) * D) + lane;
#pragma unroll
            for (int j = 0; j < 4; ++j) { xn2[j] = __builtin_nontemporal_load(xr + 64 * j); dn2[j] = __builtin_nontemporal_load(dr + 64 * j); } }
        f32x4 v[4]; float ss = 0.f;
#pragma unroll
        for (int j = 0; j < 4; ++j) { const f32x4 x = (f32x4){bflo(xa[j].x), bfhi(xa[j].x), bflo(xa[j].y), bfhi(xa[j].y)}, d = (f32x4){bflo(da[j].x), bfhi(da[j].x), bflo(da[j].y), bfhi(da[j].y)};
            v[j] = x + gt[j] * d; ss += (v[j].x * v[j].x + v[j].y * v[j].y) + (v[j].z * v[j].z + v[j].w * v[j].w); }
        const float rstd = 1.0f / sqrtf(wave_sum(ss) * (1.0f / D) + EPS);
#pragma unroll
        for (int j = 0; j < 4; ++j) wt_store16<18>(v[j] * rstd * gs[j], wt_rsrc(out, (unsigned)M * D * 4u), (unsigned)r * (D * 4u) + (unsigned)lane * 16u + j * 1024u);
#pragma unroll
        for (int j = 0; j < 4; ++j) { xa[j] = xn1[j]; xn1[j] = xn2[j]; da[j] = dn1[j]; dn1[j] = dn2[j]; }
    }
}

constexpr int LDS_BYTES = 163840;
constexpr int LDS_RSTD = 131072 + 1024, LDS_SWT = LDS_RSTD + 11 * 1024, MAXU = 11;
template <class Sched> __device__ __forceinline__ void fill_norm_tables(LAS unsigned char* lds, const Sched& S, const float* rss, const float* sW, int nw, int tid) {
    LAS float* rstdL = (LAS float*)(lds + LDS_RSTD); LAS float* swL = (LAS float*)(lds + LDS_SWT);
    constexpr int NU = 6;
    pg8::Unit u[NU]; bool ok[NU]; f32x4 q[NU]; float sv[NU];
#pragma unroll
    for (int ui = 0; ui < NU; ++ui) { ok[ui] = S.next(ui, u[ui]); q[ui] = (f32x4){0.f, 0.f, 0.f, 0.f}; sv[ui] = 0.f;
        if (ok[ui]) { if (tid < 256) { const f32x4* p = (const f32x4*)(rss + (size_t)(u[ui].pm * 256 + tid) * 16); q[ui] = (p[0] + p[1]) + (p[2] + p[3]); }
                      else sv[ui] = sW[(size_t)(u[ui].pm >> 4) * nw + u[ui].pn * 256 + tid - 256]; } }
#pragma unroll
    for (int ui = 0; ui < NU; ++ui) if (ok[ui]) { if (tid < 256) rstdL[ui * 256 + tid] = 1.0f / sqrtf(((q[ui].x + q[ui].y) + (q[ui].z + q[ui].w)) * (1.0f / D) + EPS); else swL[ui * 256 + tid - 256] = sv[ui]; }
    __syncthreads();
}

__global__ void __launch_bounds__(512, 2) mega_fwd(Args a) {
    extern __shared__ __attribute__((aligned(16))) unsigned char lds_raw[];
    LAS unsigned char* lds = (LAS unsigned char*)lds_raw;
    cg::grid_group grid = cg::this_grid();
    const int G = gridDim.x, bid = blockIdx.x, ngw = G * 8;
#define PHASE_IDS int tid = threadIdx.x; asm volatile("" : "+v"(tid)); const int lane = tid & 63, wave = __builtin_amdgcn_readfirstlane(tid >> 6), gw = bid * 8 + wave; \
    LAS float* scr = (LAS float*)(lds + wave * 16384); (void)lane; (void)gw; (void)scr;
#define x_in (a.in[0])
#define X (a.out)
#define mod ((float*)(a.ws + WS_MOD))
#define part ((float*)(a.ws + WS_PART))
#define W1IN ((bf16_t*)(a.ws + WS_W1IN))
#define W1OUT ((bf16_t*)(a.ws + WS_W1OUT))
#define WIN ((bf16_t*)(a.ws + WS_WIN))
#define WPOOL ((bf16_t*)(a.ws + WS_WPOOL))
#define WPUP ((bf16_t*)(a.ws + WS_WPUP))
#define WGLU ((bf16_t*)(a.ws + WS_WGLU))
#define WSUP ((bf16_t*)(a.ws + WS_WSUP))
#define WOUT ((bf16_t*)(a.ws + WS_WOUT))
#define W2IN ((bf16_t*)(a.ws + WS_W2IN))
#define W2OUT ((bf16_t*)(a.ws + WS_W2OUT))
#define BTE ((bf16_t*)(a.ws + WS_BTE))
#define BTY ((bf16_t*)(a.ws + WS_BTY))
#define Hb ((bf16_t*)(a.ws + WS_H))
#define ACT ((bf16_t*)(a.ws + WS_ACT))
#define UPOOL ((bf16_t*)(a.ws + WS_UPOOL))
#define ASSM ((bf16_t*)(a.ws + WS_ASSM))
#define Zb ((bf16_t*)(a.ws + WS_Z))
#define ZP ((bf16_t*)(a.ws + WS_ZP))
#define Eb ((float*)(a.ws + WS_E))
#define YG ((bf16_t*)(a.ws + WS_YG))
#define SG ((bf16_t*)(a.ws + WS_SG))
#define SIGP ((bf16_t*)(a.ws + WS_SIGP))
#define SIGS ((bf16_t*)(a.ws + WS_SIGS))
#define MERGED Hb
#define DELTA SIGP
#define RSS ((float*)(a.ws + WS_RSS))
#define SWIN ((float*)(a.ws + WS_SW))
#define SW2 (SWIN + BATCH * 3072)
    volatile LAS unsigned* MISC = (volatile LAS unsigned*)(lds + 131072 + 320);
    if (threadIdx.x < 16) MISC[threadIdx.x] = 0u;
    __syncthreads();
    const XcdBarrier xbar = xcd_barrier_post((unsigned*)(a.ws + WS_BAR), MISC + 8);
#define GRID_BAR() xcd_barrier(xbar)

    { PHASE_IDS
    for (int w = bid; w < NG * 8; w += G) ssm_prep_stage1(a, w >> 3, w & 7, (LAS float*)lds, tid);
    {
        const float* cvec = a.in[1]; const float* w_ada = a.in[2];
        for (int it = bid + G * wave; it < MODKC * 36 && wave < 3; it += 3 * G) {
            const int kc = it / 36, cb = it % 36;
#pragma unroll
            for (int b = 0; b < BATCH; ++b) { const float v = cvec[b * D + kc * 64 + lane]; scr[b * 64 + lane] = v * sigm(v); }
            LDS_WAIT();
            f32x4 acc[BATCH];
#pragma unroll
            for (int b = 0; b < BATCH; ++b) acc[b] = (f32x4){0.f, 0.f, 0.f, 0.f};
            const float* wp = w_ada + (size_t)(kc * 64) * NMODC + cb * 256;
            const unsigned lo4 = (unsigned)lane * 4u;
#pragma unroll 8
            for (int k = 0; k < 64; ++k) { const f32x4 w = __builtin_nontemporal_load((const f32x4*)((wp + (size_t)k * NMODC) + lo4));
#pragma unroll
                for (int b = 0; b < BATCH; ++b) acc[b] += w * scr[b * 64 + k]; }
#pragma unroll
            for (int b = 0; b < BATCH; ++b) *(f32x4*)(part + (size_t)(kc * BATCH + b) * NMODC + cb * 256 + lane * 4) = acc[b];
            LDS_WAIT();
        }
    }
    {
        constexpr int I1 = (D / 64) * (2 * FF / 32), I2 = (FF / 64) * (D / 32), I3 = (D / 64) * (3072 / 32), I4 = 4 * 2 * 4, I5 = (512 / 64) * (D / 32), I8 = (D / 64) * (D / 32);
        constexpr int NIT = 2 * I1 + 2 * I2 + I3 + I4 + 3 * I5 + I8;
        const int nmod = (bid + 2 * G < MODKC * 36) ? 3 : ((bid + G < MODKC * 36) ? 2 : ((bid < MODKC * 36) ? 1 : 0));
        const int nper = (NIT - bid + G - 1) / G;
        const int J1 = (nmod >= 8) ? 0 : ((nper * (8 - nmod) * 13) / (8 * 13 - nmod * 8) < nper ? (nper * (8 - nmod) * 13) / (8 * 13 - nmod * 8) : nper);
        const bool ismod = wave < nmod;
        const int jstart = ismod ? J1 + wave : wave - nmod, jstep = ismod ? nmod : 8 - nmod, jend = ismod ? nper : J1;
        for (int j = jstart; j < jend; j += jstep) {
            const int it = bid + G * j;
            int r = it;
            if (r < I1) { transpose_item(a.in[5], D, 2 * FF, W1IN, FF, r, scr, lane); continue; } r -= I1;
            if (r < I1) { transpose_item(a.in[26], D, 2 * FF, W2IN, FF, r, scr, lane); continue; } r -= I1;
            if (r < I2) { transpose_item(a.in[6], FF, D, W1OUT, 0, r, scr, lane); continue; } r -= I2;
            if (r < I2) { transpose_item(a.in[27], FF, D, W2OUT, 0, r, scr, lane); continue; } r -= I2;
            if (r < I3) { transpose_item(a.in[8], D, 3072, WIN, 0, r, scr, lane); continue; } r -= I3;
            if (r < I4) { const int k = r >> 3, q = r & 7, kb = q >> 2, nb = q & 3;
                transpose_block(a.in[9] + (size_t)k * 128 * 128, 128, WPOOL + (size_t)(k * 128) * PWID + k * 128, PWID, 64 * kb, 32 * nb, 32 * nb, scr, lane); continue; } r -= I4;
            if (r < I5) { transpose_item(a.in[12], 512, D, WPUP, 0, r, scr, lane); continue; } r -= I5;
            if (r < I5) { transpose_item(a.in[21], 512, D, WGLU, 512, r, scr, lane); continue; } r -= I5;
            if (r < I5) { transpose_item(a.in[23], 512, D, WSUP, 0, r, scr, lane); continue; } r -= I5;
            transpose_item(a.in[24], D, D, WOUT, 0, r, scr, lane);
        }
        for (int q = bid * 512 + tid; q < 12 * 128 * 16; q += G * 512) { const int blk = q / 2048, rem = q % 2048, row = rem >> 4, ch = rem & 15;
            const int kr = blk / 3, kk = blk % 3, kc = kk + (kk >= kr ? 1 : 0);
            *(u32x4*)(WPOOL + (size_t)(kr * 128 + row) * PWID + kc * 128 + ch * 8) = (u32x4){0u, 0u, 0u, 0u}; }
    }
    }
    if (a.ws == nullptr) grid.sync();
    GRID_BAR();
    { PHASE_IDS
        const float* b_ada = a.in[3];
        {
            const int bb = bid >> 5;
            for (int i = tid; i < 2 * D; i += 512) { float s = b_ada[i];
#pragma unroll
                for (int kc = 0; kc < MODKC; ++kc) s += part[(size_t)(kc * BATCH + bb) * NMODC + i];
                mod[(size_t)bb * NMODC + i] = s; }
            for (int i = bid * 512 + tid; i < BATCH * NMODC; i += G * 512) { float s = b_ada[i % NMODC];
#pragma unroll
                for (int kc = 0; kc < MODKC; ++kc) s += part[(size_t)kc * BATCH * NMODC + i];
                mod[i] = s; }
            asm volatile("s_waitcnt vmcnt(0)" ::: "memory"); __syncthreads();
        }
        row_pass<false, false, false>(x_in, Hb, mod, 0.f, X, a.in[4], mod, 0, Hb, gw, ngw, lane);
        const float* KTg = (const float*)(a.ws + WS_KT);
        for (int q0 = bid * 512 + tid; q0 < NG * 512 * 64; q0 += 4 * G * 512) {
            f32x4 k0[4], k1[4];
#pragma unroll
            for (int e = 0; e < 4; ++e) { const int q = q0 + e * G * 512, g = q >> 15, row = (q >> 6) & 511, ch = q & 63, t = row >> 4, h = row & 15, s = ch >> 1, hp0 = (ch & 1) * 8;
                k0[e] = (f32x4){0.f, 0.f, 0.f, 0.f}; k1[e] = k0[e];
                if (t >= s) { const float* kp = KTg + (size_t)g * (CL * 256) + (t - s) * 256 + h * 16 + hp0; k0[e] = *(const f32x4*)kp; k1[e] = *(const f32x4*)(kp + 4); } }
#pragma unroll
            for (int e = 0; e < 4; ++e) { const int q = q0 + e * G * 512, g = q >> 15, row = (q >> 6) & 511, ch = q & 63, s = ch >> 1, hp0 = (ch & 1) * 8;
                *(u32x4*)(BTY + ((size_t)(g * 512 + row) * KA + s * GH + hp0)) = pg8::pack8(k0[e], k1[e]); } }
    }
    GRID_BAR();
    {
        pg8::Gemm g{Hb, W1IN, D, D, D, 0}; pg8::StaticOrder S; S.init(M, 2 * FF, G, bid);
        pg8::EpiSwiGLU<false> E{ACT, FF, nullptr, nullptr};
        pg8::gemm_phase<pg8::EpiSwiGLU<false>, pg8::StaticOrder, true>(lds, g, S, E);
    }
    GRID_BAR();
    {
        pg8::Gemm g{ACT, W1OUT, FF, FF, FF, 0}; pg8::StaticOrder S; S.init(M, D, G, bid);
        pg8::EpiPlain E{DELTA, D};
        pg8::gemm_phase<pg8::EpiPlain, pg8::StaticOrder, true>(lds, g, S, E);
    }
    GRID_BAR();
    { PHASE_IDS
    {
        for (int row = gw; row < 3072; row += ngw) {
            const bf16_t* wrow = WIN + (size_t)row * D;
            f32x4 w[4]; { f32x4 t0, t1; pg8::unpack8(*(const u32x4*)(wrow + 8 * lane), t0, t1); w[0] = t0; w[1] = t1; pg8::unpack8(*(const u32x4*)(wrow + 512 + 8 * lane), t0, t1); w[2] = t0; w[3] = t1; }
            f32x4 sh4[BATCH][4];
#pragma unroll
            for (int b = 0; b < BATCH; ++b) { const float* sh = mod + (size_t)b * NMODC + (1 * 3 + 0) * D;
                sh4[b][0] = *(const f32x4*)(sh + 8 * lane); sh4[b][1] = *(const f32x4*)(sh + 8 * lane + 4); sh4[b][2] = *(const f32x4*)(sh + 512 + 8 * lane); sh4[b][3] = *(const f32x4*)(sh + 512 + 8 * lane + 4); }
#pragma unroll
            for (int b = 0; b < BATCH; ++b) { const f32x4 pr = (w[0] * sh4[b][0] + w[1] * sh4[b][1]) + (w[2] * sh4[b][2] + w[3] * sh4[b][3]);
                const float tot = wave_sum((pr.x + pr.y) + (pr.z + pr.w));
                if (lane == 0) SWIN[(size_t)b * 3072 + row] = tot; }
        }
    }
    resid_xg_pass(x_in, DELTA, mod + (0 * 3 + 2) * D, 0.5f, X, a.in[7], mod, 1, Hb, RSS, (bid & 7) * 256 + (bid >> 3) * 8 + wave, ngw, lane);
    }
    GRID_BAR();
    {
        pg8::Gemm g{Hb, WIN, D, D, D, 0}; pg8::StaticOrder S; S.init(M, 3072, G, bid);
        { PHASE_IDS fill_norm_tables(lds, S, RSS, SWIN, 3072, tid); }
        pg8::EpiWin E{UPOOL, ASSM, SIGP, SIGS, (const LAS float*)(lds + LDS_RSTD), (const LAS float*)(lds + LDS_SWT)};
        pg8::gemm_phase<pg8::EpiWin, pg8::StaticOrder, true>(lds, g, S, E);
    }
    GRID_BAR();
    {
        { PHASE_IDS
        const int slot = bid >> 3; const bool split = (G == 256);
        const int zw = split ? ((slot - 16) * 8 + (bid & 7)) * 8 + wave : gw, nzw = split ? 1024 : ngw;
        if (!split || slot >= 16)
            for (int tb = zw; tb < M / 16; tb += nzw) { zpass_group<2>(UPOOL, Zb, tb, 0, lane); zpass_group<4>(UPOOL, Zb, tb, 1, lane); zpass_group<8>(UPOOL, Zb, tb, 2, lane); zpass_group<16>(UPOOL, Zb, tb, 3, lane); } }
        pg8::Gemm g{ASSM, BTE, KA, 512, 512, 0}; pg8::OrderE S{G, bid};
        pg8::EpiE E{Eb};
        pg8::gemm_phase<pg8::EpiE, pg8::OrderE, false>(lds, g, S, E);
    }
    GRID_BAR();
    {
        { PHASE_IDS
        const float* A32 = (const float*)(a.ws + WS_A32);
        LAS float* EL = (LAS float*)lds; LAS bf16_t* OL = (LAS bf16_t*)(lds + 65536);
        for (int item = bid; item < NG * BATCH; item += G) {
            const int g = item >> 3, b = item & 7; const size_t row0 = (size_t)g * RPG + b * NCH;
            const f32x4* src = (const f32x4*)(Eb + row0 * 128);
            f32x4 ev[8];
#pragma unroll
            for (int i = 0; i < 8; ++i) ev[i] = src[tid + 512 * i];
#pragma unroll
            for (int i = 0; i < 8; ++i) *(LAS f32x4*)(EL + 4 * (tid + 512 * i)) = ev[i];
            __syncthreads();
            if (wave == 0) { const int n = lane;
                const float ar = A32[(g * NS + n) * 2], ai = A32[(g * NS + n) * 2 + 1];
                float sr = 0.f, si = 0.f;
#pragma unroll 8
                for (int c = 0; c < NCH; ++c) { const float er = EL[c * 128 + n], ei = EL[c * 128 + 64 + n];
                    OL[c * 128 + n] = (bf16_t)f2bf(sr); OL[c * 128 + 64 + n] = (bf16_t)f2bf(si);
                    const float q = ar * sr - ai * si + er; si = ar * si + ai * sr + ei; sr = q; } }
            __syncthreads();
#pragma unroll
            for (int i = 0; i < 4; ++i) { const int q = tid + 512 * i, c = q >> 4, k = q & 15;
                *(u32x4*)(ASSM + (row0 + c) * KA + 512 + k * 8) = *(const LAS u32x4*)(OL + c * 128 + k * 8); }
            __syncthreads();
        } }
        pg8::Gemm g{Zb, WPOOL, PWID, PWID, 256, 256 * 2};     pg8::StaticOrder S; S.init(M, PWID, G, bid);
        pg8::EpiPool1 E{ZP, a.in[10], a.in[11]};
        pg8::gemm_phase<pg8::EpiPool1, pg8::StaticOrder, false>(lds, g, S, E);
    }
    GRID_BAR();
    {
        { pg8::Gemm g{ASSM, BTY, KA, KA, KA, 0}; pg8::OrderY S{G, bid}; pg8::EpiY E{YG, ASSM, a.in[20]};
          pg8::gemm_phase<pg8::EpiY, pg8::OrderY, false>(lds, g, S, E); }
        { pg8::Gemm g{ZP, WPUP, PWID, PWID, PWID, 0}; pg8::StaticOrder S; S.init(M, D, G, bid); pg8::EpiGateAcc<false> E{MERGED, SIGP};
          pg8::gemm_phase<pg8::EpiGateAcc<false>, pg8::StaticOrder, true>(lds, g, S, E); }
    }
    GRID_BAR();
    {
        pg8::Gemm g{YG, WGLU, SWID, SWID, SWID, 0}; pg8::StaticOrder S; S.init(M, 2 * SWID, G, bid);
        pg8::EpiGLU E{SG, SWID, a.in[22], SWID};
        pg8::gemm_phase<pg8::EpiGLU, pg8::StaticOrder, true>(lds, g, S, E);
    }
    GRID_BAR();
    {
        pg8::Gemm g{SG, WSUP, SWID, SWID, SWID, 0}; pg8::StaticOrder S; S.init(M, D, G, bid);
        pg8::EpiGateAcc<true> E{MERGED, SIGS};
        pg8::gemm_phase<pg8::EpiGateAcc<true>, pg8::StaticOrder, true>(lds, g, S, E);
    }
    GRID_BAR();
    {
        pg8::Gemm g{MERGED, WOUT, D, D, D, 0}; pg8::StaticOrder S; S.init(M, D, G, bid);
        pg8::EpiPlain E{DELTA, D};
        pg8::gemm_phase<pg8::EpiPlain, pg8::StaticOrder, true>(lds, g, S, E);
    }
    GRID_BAR();
    { PHASE_IDS
    row_pass<true, true, false, true>(X, DELTA, mod + (1 * 3 + 2) * D, 1.0f, (float*)SIGS  , a.in[25], mod, 2, Hb, (bid & 7) * 256 + (bid >> 3) * 8 + wave, ngw, lane);
    }
    GRID_BAR();
    {
        pg8::Gemm g{Hb, W2IN, D, D, D, 0}; pg8::StaticOrder S; S.init(M, 2 * FF, G, bid);
        pg8::EpiSwiGLU<false> E{ACT, FF, nullptr, nullptr};
        pg8::gemm_phase<pg8::EpiSwiGLU<false>, pg8::StaticOrder, true>(lds, g, S, E);
    }
    GRID_BAR();
    {
        pg8::Gemm g{ACT, W2OUT, FF, FF, FF, 0}; pg8::StaticOrder S; S.init(M, D, G, bid);
        pg8::EpiPlain E{DELTA, D};
        pg8::gemm_phase<pg8::EpiPlain, pg8::StaticOrder, true>(lds, g, S, E);
    }
    GRID_BAR();
    { PHASE_IDS
    final_pass_bf16x(SIGS, DELTA, mod + (2 * 3 + 2) * D, 0.5f, X, a.in[28], (bid & 7) * 256 + (bid >> 3) * 8 + wave, lane);
    }
}

extern "C" void kernel_launch(void* const* d_in, const int* in_sizes, int n_in, void* d_out, int out_size, void* d_ws, size_t ws_size, hipStream_t stream) {
    static int grid_blocks = 0;
    if (grid_blocks == 0) {
        if (n_in != 29 || out_size != M * D || ws_size < WS_END) { fprintf(stderr, "kernel_launch: unexpected problem (n_in %d out %d ws %zu)\n", n_in, out_size, ws_size); grid_blocks = -1; return; }
        int dev = 0, cus = 0, per_cu = 0;
        (void)hipGetDevice(&dev);
        (void)hipDeviceGetAttribute(&cus, hipDeviceAttributeMultiprocessorCount, dev);
        (void)hipFuncSetAttribute((const void*)mega_fwd, hipFuncAttributeMaxDynamicSharedMemorySize, LDS_BYTES);
        (void)hipOccupancyMaxActiveBlocksPerMultiprocessor(&per_cu, (const void*)mega_fwd, 512, LDS_BYTES);
        (void)hipGetLastError();
        if (per_cu < 1) per_cu = 1;
        grid_blocks = cus * per_cu;
        if (grid_blocks != 256) { fprintf(stderr, "kernel_launch: built for a 256-workgroup grid (got %d)\n", grid_blocks); grid_blocks = -1; return; }
    }
    if (grid_blocks < 0) return;
    Args a{};
    for (int i = 0; i < 29; ++i) a.in[i] = (const float*)d_in[i];
    a.out = (float*)d_out; a.ws = (unsigned char*)d_ws;
    (void)hipMemsetAsync((unsigned char*)d_ws + WS_BAR, 0, BAR_BYTES, stream);
    void* args[] = {&a};
    hipError_t e = hipLaunchCooperativeKernel((const void*)mega_fwd, dim3(grid_blocks), dim3(512), args, LDS_BYTES, stream);
    if (e != hipSuccess) fprintf(stderr, "cooperative launch failed: %s (grid %d)\n", hipGetErrorString(e), grid_blocks);
}
```

```cpp
#include <hip/hip_runtime.h>
#include <hip/hip_cooperative_groups.h>
#include <cstdio>
namespace cg = cooperative_groups;

#define LAS __attribute__((address_space(3)))
typedef unsigned short bf16_t;
typedef short bf16x8 __attribute__((ext_vector_type(8)));
typedef float f32x4 __attribute__((ext_vector_type(4)));
typedef unsigned u32x4 __attribute__((ext_vector_type(4)));
typedef unsigned u32x2 __attribute__((ext_vector_type(2)));

constexpr int D = 1024, BATCH = 8, SEQ = 4096, M = BATCH * SEQ, FF = 2816, NMODC = 9 * D;
constexpr int PWID = 512, SWID = 512, NG = 32, GH = 16, NS = 64;
constexpr int CL = 32, NCH = SEQ / CL, RPG = BATCH * NCH  , KA = 640  ;
constexpr float EPS = 1e-6f;
constexpr int MODKC = 16;

constexpr size_t MiB = 1u << 20;
constexpr size_t WS_PART = 0, WS_MOD = 5 * MiB, WS_A32 = 5 * MiB + 512 * 1024, WS_BAR = 5 * MiB + 768 * 1024, BAR_BYTES = 16384;
constexpr size_t WS_W1IN = 6 * MiB, WS_W1OUT = 17 * MiB, WS_WIN = 23 * MiB, WS_WPOOL = 29 * MiB, WS_WPUP = 30 * MiB, WS_WGLU = 31 * MiB,
                 WS_WSUP = 32 * MiB, WS_WOUT = 33 * MiB, WS_W2IN = 35 * MiB, WS_W2OUT = 46 * MiB, WS_BTE = 52 * MiB, WS_BTY = 60 * MiB;
constexpr size_t WS_H = 80 * MiB;
constexpr size_t WS_ACT = 144 * MiB;
constexpr size_t WS_UPOOL = 144 * MiB, WS_ASSM = 176 * MiB, WS_Z = 216 * MiB, WS_ZP = 248 * MiB, WS_E = 280 * MiB;
constexpr size_t WS_YG = WS_UPOOL, WS_SG = WS_Z;
constexpr size_t WS_SIGP = 320 * MiB, WS_SIGS = 384 * MiB, WS_RSS = 448 * MiB  , WS_SW = 450 * MiB  , WS_KT = 451 * MiB  , WS_END = 452 * MiB;

__device__ __forceinline__ unsigned cvt_pk_bf16(float lo, float hi) { unsigned r; asm volatile("v_cvt_pk_bf16_f32 %0, %1, %2" : "=v"(r) : "v"(lo), "v"(hi)); return r; }
__device__ __forceinline__ unsigned f2bf(float f) { unsigned u = __builtin_bit_cast(unsigned, f); return (u + 0x7fffu + ((u >> 16) & 1u)) >> 16; }
__device__ __forceinline__ float bflo(unsigned w) { return __builtin_bit_cast(float, w << 16); }
__device__ __forceinline__ float bfhi(unsigned w) { return __builtin_bit_cast(float, w & 0xffff0000u); }
__device__ __forceinline__ float sigm(float x) { return __builtin_amdgcn_rcpf(1.0f + __builtin_amdgcn_exp2f(x * -1.4426950408889634f)); }
typedef float f32x2 __attribute__((ext_vector_type(2)));
__device__ __forceinline__ f32x2 sigm2(f32x2 x) { const f32x2 t = x * -1.4426950408889634f; f32x2 e; e.x = __builtin_amdgcn_exp2f(t.x); e.y = __builtin_amdgcn_exp2f(t.y); const f32x2 d = e + 1.0f; f32x2 r; r.x = __builtin_amdgcn_rcpf(d.x); r.y = __builtin_amdgcn_rcpf(d.y); return r; }
__device__ __forceinline__ f32x4 sigm4(f32x4 x) { const f32x2 lo = sigm2((f32x2){x.x, x.y}), hi = sigm2((f32x2){x.z, x.w}); return (f32x4){lo.x, lo.y, hi.x, hi.y}; }
__device__ __forceinline__ f32x2 gelu_pk(f32x2 v) {
    const f32x2 av = __builtin_elementwise_abs(v), d = av * 0.2316418882f + 1.0f;
    f32x2 t; t.x = __builtin_amdgcn_rcpf(d.x); t.y = __builtin_amdgcn_rcpf(d.y);
    f32x2 q = t * 0.5307027145f + (-0.7265760135f); q = q * t + 0.7107068705f; q = q * t + (-0.142248368f); q = q * t + 0.127414796f; q = q * t;
    const f32x2 s = (v * v) * (-0.72134752044f);
    f32x2 e; e.x = __builtin_amdgcn_exp2f(s.x); e.y = __builtin_amdgcn_exp2f(s.y);
    const f32x2 m = v * (q * e), r = v - m;
    f32x2 o; o.x = v.x < 0.f ? m.x : r.x; o.y = v.y < 0.f ? m.y : r.y; return o;
}
__device__ __forceinline__ float wave_sum(float v) {
#pragma unroll
    for (int o = 1; o < 64; o <<= 1) v += __shfl_xor(v, o);
    return v;
}
#define LDS_WAIT() asm volatile("s_waitcnt lgkmcnt(0)" ::: "memory")

namespace pg8 {
constexpr int BM = 256, BK = 64, HALF = 128, HTB = HALF * BK * 2, STAGE_BYTES = 8 * HTB, NXCD = 8, WGM = 8;
__host__ __device__ __forceinline__ int lds_byte(int r, int c) { const int st = (r >> 4) * 2 + (c >> 5), rr = r & 15, cc = c & 31, ob = rr * 64 + cc * 2; return st * 1024 + (ob ^ (((ob >> 9) & 1) << 5)); }
__host__ __device__ __forceinline__ void stage_rc(int b, int& R, int& C) { const int st = b / 1024, sb = b % 1024, swz = sb ^ (((sb >> 9) & 1) << 5); R = (st >> 1) * 16 + swz / 64; C = (st & 1) * 32 + (swz % 64) / 2; }
__host__ __device__ __forceinline__ int perm32(int rho) { const int n = rho >> 4, i = rho & 15; return 8 * (i >> 2) + 4 * n + (i & 3); }

struct Unit { int pm, pn; };
struct Gemm { const bf16_t* A; const bf16_t* Bt; int lda, ldb, K; int kpn; };

struct StaticOrder {
    int nM, nN, nwg, G, c;
    __device__ void init(int Mr, int Nc, int G_, int c_) { nM = Mr / BM; nN = Nc / BM; nwg = nM * nN; G = G_; c = c_; }
    __device__ bool next(int i, Unit& u) const {
        const long L = (long)i * G + c; if (L >= nwg) return false;
        int wgid = (int)L; { const int q = nwg / NXCD, r = nwg % NXCD, xcd = wgid % NXCD, off = wgid / NXCD; wgid = (xcd < r ? xcd * (q + 1) : r * (q + 1) + (xcd - r) * q) + off; }
        const int nig = WGM * nN, gid = wgid / nig, fm = gid * WGM, gsz = (nM - fm) < WGM ? (nM - fm) : WGM;
        u.pm = fm + ((wgid % nig) % gsz); u.pn = (wgid % nig) / gsz; return true;
    }
};
struct OrderE {
    int G, c;
    __device__ bool next(int i, Unit& u) const { const int xcd = c & 7, slot = c >> 3; if (i > 0 || G != 256 || slot >= 16) return false; const int g = xcd * 4 + (slot >> 2); u.pm = g * 4 + (slot & 3); u.pn = g; return true; }
};
struct OrderY {
    int G, c;
    __device__ bool next(int i, Unit& u) const { const int xcd = c & 7, slot = c >> 3; if (i > 0 || G != 256) return false; const int g = xcd * 4 + (slot >> 3), rem = slot & 7; u.pm = g * 4 + (rem & 3); u.pn = g * 2 + (rem >> 2); return true; }
};

struct EpiEC;
template <class T> struct epi_after_drain { static constexpr bool value = false; };
template <> struct epi_after_drain<EpiEC> { static constexpr bool value = true; };
template <class Epi, class Sched, bool ALIGN_EPI>
__device__ __forceinline__ void gemm_phase(LAS unsigned char* lds, const Gemm g, const Sched& S, const Epi& E) {
    int tid_ = threadIdx.x; asm volatile("" : "+v"(tid_));
    const int tid = tid_, wid = __builtin_amdgcn_readfirstlane(tid >> 6), lane = tid & 63, wr = wid >> 2, wc = wid & 3, fr = lane & 15, fq = lane >> 4;
    const int K = g.K, nt = K / BK;
    unsigned voffA[2], voffB[2];
#pragma unroll
    for (int i = 0; i < 2; ++i) { int R, C; stage_rc(tid * 16 + i * 8192, R, C); const int Rb = Epi::PERM ? ((R & ~31) + perm32(R & 31)) : R;
        voffA[i] = (unsigned)(R * g.lda + C) * 2u; voffB[i] = (unsigned)(Rb * g.ldb + C) * 2u; }
    const size_t kstep = (size_t)(BK * 2);
    const size_t hstepA = (size_t)HALF * g.lda * 2, hstepB = (size_t)HALF * g.ldb * 2;
    const size_t tstepA = 2 * hstepA, tstepB = 2 * hstepB;
    const unsigned ldsw = (unsigned)wid * 1024u;
    const int aoff = lds_byte(wr * 64 + fr, fq * 8), boff = lds_byte(wc * 32 + fr, fq * 8);
#define PG8_SA(b, h) (((b) * 2 + (h)) * HTB)
#define PG8_SB(b, h) ((4 + (b) * 2 + (h)) * HTB)
#define PG8_STAGE(bufoff, gbase, voff) do { _Pragma("unroll") for (int _i = 0; _i < 2; ++_i) \
        __builtin_amdgcn_global_load_lds((const unsigned*)((const char*)(gbase) + (voff)[_i]), (LAS unsigned*)(lds + (bufoff) + ldsw + _i * 8192), 16, 0, 0); } while (0)
#define PG8_LDA(dst, b, h) do { _Pragma("unroll") for (int m = 0; m < 4; ++m) _Pragma("unroll") for (int k = 0; k < 2; ++k) dst[m][k] = *(const LAS bf16x8*)(lds + PG8_SA(b, h) + aoff + m * 2048 + k * 1024); } while (0)
#define PG8_LDB(dst, b, h) do { _Pragma("unroll") for (int n = 0; n < 2; ++n) _Pragma("unroll") for (int k = 0; k < 2; ++k) dst[n][k] = *(const LAS bf16x8*)(lds + PG8_SB(b, h) + boff + n * 2048 + k * 1024); } while (0)
#define PG8_MMA(ai, bj, At, Bt) do { __builtin_amdgcn_s_setprio(1); _Pragma("unroll") for (int m = 0; m < 4; ++m) _Pragma("unroll") for (int n = 0; n < 2; ++n) _Pragma("unroll") for (int k = 0; k < 2; ++k) \
        acc[ai][bj][m][n] = __builtin_amdgcn_mfma_f32_16x16x32_bf16(Bt[n][k], At[m][k], acc[ai][bj][m][n], 0, 0, 0); __builtin_amdgcn_s_setprio(0); } while (0)
#define PG8_WAIT_V(n) asm volatile("s_waitcnt vmcnt(" #n ")" ::: "memory")
#define PG8_WAIT_L(n) asm volatile("s_waitcnt lgkmcnt(" #n ")" ::: "memory")
#define PG8_BAR __builtin_amdgcn_s_barrier()
#define PG8_SCHED __builtin_amdgcn_sched_barrier(0)
    Unit cur, nxt; int ui = 0;
    if (!S.next(0, cur)) return;
    f32x4 acc[2][2][4][2];
#pragma unroll
    for (int a = 0; a < 2; ++a)
#pragma unroll
        for (int b = 0; b < 2; ++b)
#pragma unroll
            for (int m = 0; m < 4; ++m)
#pragma unroll
                for (int n = 0; n < 2; ++n) acc[a][b][m][n] = (f32x4){0.f, 0.f, 0.f, 0.f};
    bf16x8 At[4][2], B0[2][2], B1[2][2];
    const char* cA = (const char*)g.A + (size_t)cur.pm * tstepA + (size_t)cur.pn * g.kpn; const char* cB = (const char*)g.Bt + (size_t)cur.pn * tstepB + (size_t)cur.pn * g.kpn;
    PG8_STAGE(PG8_SB(0, 0), cB, voffB); PG8_STAGE(PG8_SB(0, 1), cB + hstepB, voffB); PG8_STAGE(PG8_SA(0, 0), cA, voffA); PG8_STAGE(PG8_SA(0, 1), cA + hstepA, voffA);
    if (wr == 1) PG8_BAR;
    PG8_WAIT_V(2); PG8_BAR;
    PG8_STAGE(PG8_SB(1, 0), cB + kstep, voffB); PG8_STAGE(PG8_SA(1, 0), cA + kstep, voffA); PG8_STAGE(PG8_SB(1, 1), cB + hstepB + kstep, voffB);
    PG8_WAIT_V(6); PG8_BAR;
    for (;;) {
        const bool has_next = S.next(ui + 1, nxt);
        const char* nA = has_next ? (const char*)g.A + (size_t)nxt.pm * tstepA + (size_t)nxt.pn * g.kpn : cA; const char* nB = has_next ? (const char*)g.Bt + (size_t)nxt.pn * tstepB + (size_t)nxt.pn * g.kpn : cB;
#pragma nounroll
        for (int t = 0; t < nt; t += 2) {
            const bool last = (t == nt - 2);
            const char* a1 = cA + (size_t)(t + 1) * kstep;
            const char* a2 = last ? nA : cA + (size_t)(t + 2) * kstep; const char* b2 = last ? nB : cB + (size_t)(t + 2) * kstep;
            const char* a3 = a2 + kstep; const char* b3 = b2 + kstep;
            PG8_LDB(B0, 0, 0); PG8_LDB(B1, 0, 1); PG8_SCHED; PG8_LDA(At, 0, 0); PG8_STAGE(PG8_SA(1, 1), a1 + hstepA, voffA);
            PG8_WAIT_V(8); PG8_WAIT_L(0); PG8_BAR; PG8_MMA(0, 0, At, B0); PG8_MMA(0, 1, At, B1); PG8_BAR; PG8_SCHED;
            PG8_LDA(At, 0, 1); PG8_STAGE(PG8_SB(0, 0), b2, voffB); PG8_STAGE(PG8_SB(0, 1), b2 + hstepB, voffB); PG8_STAGE(PG8_SA(0, 0), a2, voffA);
            PG8_WAIT_V(8); PG8_WAIT_L(0); PG8_BAR; PG8_MMA(1, 0, At, B0); PG8_MMA(1, 1, At, B1); PG8_BAR; PG8_SCHED;
            PG8_LDB(B0, 1, 0); PG8_LDB(B1, 1, 1); PG8_SCHED; PG8_LDA(At, 1, 0); PG8_STAGE(PG8_SA(0, 1), a2 + hstepA, voffA);
            PG8_WAIT_V(8); PG8_WAIT_L(0); PG8_BAR; PG8_MMA(0, 0, At, B0); PG8_MMA(0, 1, At, B1); PG8_BAR; PG8_SCHED;
            PG8_LDA(At, 1, 1); PG8_STAGE(PG8_SB(1, 0), b3, voffB); PG8_STAGE(PG8_SB(1, 1), b3 + hstepB, voffB); PG8_STAGE(PG8_SA(1, 0), a3, voffA);
            PG8_WAIT_V(8); PG8_WAIT_L(0); PG8_BAR; PG8_MMA(1, 0, At, B0); PG8_MMA(1, 1, At, B1); PG8_BAR; PG8_SCHED;
        }
        if constexpr (ALIGN_EPI) { if (wr == 0) PG8_BAR; }
        if constexpr (!epi_after_drain<Epi>::value) E(acc, cur, ui, wr, wc, fr, fq);
        if (!has_next) break;
#pragma unroll
        for (int a = 0; a < 2; ++a)
#pragma unroll
            for (int b = 0; b < 2; ++b)
#pragma unroll
                for (int m = 0; m < 4; ++m)
#pragma unroll
                    for (int n = 0; n < 2; ++n) acc[a][b][m][n] = (f32x4){0.f, 0.f, 0.f, 0.f};
        cur = nxt; cA = nA; cB = nB; ++ui;
        if constexpr (ALIGN_EPI) { if (wr == 1) PG8_BAR; }
    }
    PG8_WAIT_V(0);
    if constexpr (!ALIGN_EPI) { if (wr == 0) PG8_BAR; }
    PG8_BAR;
    if constexpr (epi_after_drain<Epi>::value) E.fused(acc, cur, wr, wc, fr, fq, lds, wid, lane);
#undef PG8_SA
#undef PG8_SB
#undef PG8_STAGE
#undef PG8_LDA
#undef PG8_LDB
#undef PG8_MMA
#undef PG8_WAIT_V
#undef PG8_WAIT_L
#undef PG8_BAR
#undef PG8_SCHED
}

typedef f32x4 Acc[2][2][4][2];

__device__ __forceinline__ u32x4 pack8(const f32x4 v0, const f32x4 v1) { u32x4 w; w.x = cvt_pk_bf16(v0[0], v0[1]); w.y = cvt_pk_bf16(v0[2], v0[3]); w.z = cvt_pk_bf16(v1[0], v1[1]); w.w = cvt_pk_bf16(v1[2], v1[3]); return w; }
__device__ __forceinline__ void unpack8(const u32x4 w, f32x4& v0, f32x4& v1) { v0 = (f32x4){bflo(w.x), bfhi(w.x), bflo(w.y), bfhi(w.y)}; v1 = (f32x4){bflo(w.z), bfhi(w.z), bflo(w.w), bfhi(w.w)}; }

template <bool NORM> struct EpiSwiGLU {
    static constexpr bool PERM = true;
    bf16_t* O; int ldo; const LAS float* rstdL; const LAS float* swL;
    __device__ __forceinline__ void operator()(const Acc& acc, const Unit& u, int ui, int wr, int wc, int fr, int fq) const {
        const int col0 = u.pn * HALF + wc * 32 + 8 * fq;
        f32x4 sa[2], sb[2];
        if (NORM) { const LAS float* sp = swL + ui * 256 + wc * 32 + 8 * fq;
#pragma unroll
            for (int n = 0; n < 2; ++n) { sa[n] = *(const LAS f32x4*)(sp + 4 * n); sb[n] = *(const LAS f32x4*)(sp + HALF + 4 * n); } }
#pragma unroll
        for (int ai = 0; ai < 2; ++ai)
#pragma unroll
            for (int m = 0; m < 4; ++m) {
                const int rl = wr * 64 + fr + ai * HALF + m * 16, r = u.pm * BM + rl;
                float rstd = 1.0f;
                if (NORM) rstd = rstdL[ui * 256 + rl];
                f32x4 v[2];
#pragma unroll
                for (int n = 0; n < 2; ++n) { f32x4 a = acc[ai][0][m][n], b = acc[ai][1][m][n];
                    if (NORM) { a = a * rstd + sa[n]; b = b * rstd + sb[n]; }
                    v[n] = (a * b) * sigm4(a); }
                *(u32x4*)(O + (size_t)r * ldo + col0) = pack8(v[0], v[1]);
            }
    }
};
struct EpiGLU {
    static constexpr bool PERM = true;
    bf16_t* O; int ldo; const float* bias; int nhalf;
    __device__ __forceinline__ void operator()(const Acc& acc, const Unit& u, int ui, int wr, int wc, int fr, int fq) const {
        const int row0 = u.pm * BM + wr * 64 + fr, col0 = u.pn * HALF + wc * 32 + 8 * fq;
        f32x4 bv[2], bg[2];
#pragma unroll
        for (int n = 0; n < 2; ++n) { bv[n] = *(const f32x4*)(bias + col0 + 4 * n); bg[n] = *(const f32x4*)(bias + nhalf + col0 + 4 * n); }
#pragma unroll
        for (int ai = 0; ai < 2; ++ai)
#pragma unroll
            for (int m = 0; m < 4; ++m) {
                f32x4 v[2];
#pragma unroll
                for (int n = 0; n < 2; ++n) { const f32x4 a = acc[ai][0][m][n] + bv[n], b = acc[ai][1][m][n] + bg[n];
                    v[n] = a * sigm4(b); }
                *(u32x4*)(O + (size_t)(row0 + ai * HALF + m * 16) * ldo + col0) = pack8(v[0], v[1]);
            }
    }
};
template <bool NEXT, bool HALFS> struct EpiResid {
    static constexpr bool PERM = false;
    static constexpr float s = HALFS ? 0.5f : 1.0f;
    const float* base; float* out; const float* gate0;
    bf16_t* xg; const float* gnext; const float* scale0; float* rss;
    __device__ __forceinline__ void operator()(const Acc& acc, const Unit& u, int ui, int wr, int wc, int fr, int fq) const {
        const int row0 = u.pm * BM + wr * 64 + fr, col0 = u.pn * BM + wc * 32 + 4 * fq;
        const float* gate = gate0 + (size_t)(u.pm >> 4) * NMODC;
        const char* bp = (const char*)base; char* op = (char*)out; char* xp = (char*)xg;
        unsigned rb[2][4];
        float ss[2][4];
#pragma unroll
        for (int ai = 0; ai < 2; ++ai)
#pragma unroll
            for (int m = 0; m < 4; ++m) { ss[ai][m] = 0.f; rb[ai][m] = (unsigned)((row0 + ai * HALF + m * 16) * D + col0) * 4u; }
#pragma unroll
        for (int bj = 0; bj < 2; ++bj)
#pragma unroll
            for (int n = 0; n < 2; ++n) {
                const int c = col0 + bj * HALF + n * 16; const unsigned cb = (unsigned)(bj * HALF + n * 16) * 4u;
                f32x4 bs[2][4];
#pragma unroll
                for (int ai = 0; ai < 2; ++ai)
#pragma unroll
                    for (int m = 0; m < 4; ++m) bs[ai][m] = *(const f32x4*)(bp + (rb[ai][m] + cb));
                const f32x4 gv = *(const f32x4*)(gate + c) * s;
                f32x4 gsv = gv;
                if (NEXT) gsv = *(const f32x4*)(gnext + c) * (*(const f32x4*)(scale0 + (size_t)(u.pm >> 4) * NMODC + c) + 1.0f);
#pragma unroll
                for (int ai = 0; ai < 2; ++ai)
#pragma unroll
                    for (int m = 0; m < 4; ++m) {
                        const f32x4 xn = bs[ai][m] + gv * acc[ai][bj][m][n];
                        *(f32x4*)(op + (rb[ai][m] + cb)) = xn;
                        if (NEXT) { ss[ai][m] += (xn.x * xn.x + xn.y * xn.y) + (xn.z * xn.z + xn.w * xn.w); const f32x4 o = xn * gsv; u32x2 w; w.x = cvt_pk_bf16(o.x, o.y); w.y = cvt_pk_bf16(o.z, o.w);
                            *(u32x2*)(xp + ((rb[ai][m] + cb) >> 1)) = w; } }
            }
        if (NEXT) {
#pragma unroll
            for (int ai = 0; ai < 2; ++ai)
#pragma unroll
                for (int m = 0; m < 4; ++m) { float t = ss[ai][m]; t += __shfl_xor(t, 16); t += __shfl_xor(t, 32); if (fq == 0) rss[(size_t)(row0 + ai * HALF + m * 16) * 16 + u.pn * 4 + wc] = t; }
        }
    }
};
struct EpiWin {
    static constexpr bool PERM = true;
    bf16_t *upool, *assm, *sigp, *sigs; const LAS float* rstdL; const LAS float* swL;
    __device__ __forceinline__ void operator()(const Acc& acc, const Unit& u, int ui, int wr, int wc, int fr, int fq) const {
        const int pn = u.pn;
        f32x4 sv[2][2];
        { const LAS float* sp = swL + ui * 256 + wc * 32 + 8 * fq;
#pragma unroll
          for (int bj = 0; bj < 2; ++bj)
#pragma unroll
              for (int n = 0; n < 2; ++n) sv[bj][n] = *(const LAS f32x4*)(sp + bj * HALF + 4 * n); }
#pragma unroll
        for (int ai = 0; ai < 2; ++ai)
#pragma unroll
            for (int m = 0; m < 4; ++m) { const int rl = wr * 64 + fr + ai * HALF + m * 16, r = u.pm * BM + rl;
                const float rstd = rstdL[ui * 256 + rl];
#pragma unroll
                for (int bj = 0; bj < 2; ++bj) {
                    f32x4 v0 = acc[ai][bj][m][0] * rstd + sv[bj][0], v1 = acc[ai][bj][m][1] * rstd + sv[bj][1];
                    const int cl = bj * HALF + wc * 32 + 8 * fq;
                    if (pn < 2) { *(u32x4*)(upool + (size_t)r * PWID + pn * BM + cl) = pack8(v0, v1); }
                    else if (pn < 4) { const int cs = (pn - 2) * BM + cl, g = cs >> 4, h0 = cs & 15;
                        *(u32x4*)(assm + ((size_t)(g * RPG + (r >> 5)) * KA + (r & 31) * GH + h0)) = pack8(v0, v1); }
                    else {
                        v0 = sigm4(v0); v1 = sigm4(v1);
                        bf16_t* dst = (pn < 8) ? (sigp + (size_t)r * D + (pn - 4) * BM + cl) : (sigs + (size_t)r * D + (pn - 8) * BM + cl);
                        *(u32x4*)dst = pack8(v0, v1); }
                } }
    }
};
struct EpiPool1 {
    static constexpr bool PERM = true;
    bf16_t* O; const float* pb; const float* ps;
    __device__ __forceinline__ void operator()(const Acc& acc, const Unit& u, int ui, int wr, int wc, int fr, int fq) const {
        const int row0 = u.pm * BM + wr * 64 + fr, col0 = u.pn * BM + wc * 32 + 8 * fq;
        f32x4 b[2][2], s[2][2];
#pragma unroll
        for (int bj = 0; bj < 2; ++bj)
#pragma unroll
            for (int n = 0; n < 2; ++n) { b[bj][n] = *(const f32x4*)(pb + col0 + bj * HALF + 4 * n); s[bj][n] = *(const f32x4*)(ps + col0 + bj * HALF + 4 * n); }
#pragma unroll
        for (int ai = 0; ai < 2; ++ai)
#pragma unroll
            for (int m = 0; m < 4; ++m) { bf16_t* rowp = O + (size_t)(row0 + ai * HALF + m * 16) * PWID + col0;
#pragma unroll
                for (int bj = 0; bj < 2; ++bj) *(u32x4*)(rowp + bj * HALF) = pack8((acc[ai][bj][m][0] + b[bj][0]) * s[bj][0], (acc[ai][bj][m][1] + b[bj][1]) * s[bj][1]); }
    }
};
template <bool ADD> struct EpiGateAcc {
    static constexpr bool PERM = true;
    bf16_t* O; const bf16_t* sig;
    __device__ __forceinline__ void operator()(const Acc& acc, const Unit& u, int ui, int wr, int wc, int fr, int fq) const {
        const int row0 = u.pm * BM + wr * 64 + fr, col0 = u.pn * BM + wc * 32 + 8 * fq;
#pragma unroll
        for (int ai = 0; ai < 2; ++ai) {
            u32x4 sg[4][2], pv[4][2];
#pragma unroll
            for (int m = 0; m < 4; ++m)
#pragma unroll
                for (int bj = 0; bj < 2; ++bj) { const size_t off = (size_t)(row0 + ai * HALF + m * 16) * D + col0 + bj * HALF; sg[m][bj] = *(const u32x4*)(sig + off); if (ADD) pv[m][bj] = *(const u32x4*)(O + off); }
#pragma unroll
            for (int m = 0; m < 4; ++m) { const size_t off = (size_t)(row0 + ai * HALF + m * 16) * D + col0;
#pragma unroll
                for (int bj = 0; bj < 2; ++bj) { f32x4 s0, s1; unpack8(sg[m][bj], s0, s1);
                    f32x4 v0 = s0 * acc[ai][bj][m][0], v1 = s1 * acc[ai][bj][m][1];
                    if (ADD) { f32x4 p0, p1; unpack8(pv[m][bj], p0, p1); v0 += p0; v1 += p1; }
                    *(u32x4*)(O + off + bj * HALF) = pack8(v0, v1); } }
        }
    }
};
struct EpiPlain {
    static constexpr bool PERM = true;
    bf16_t* O; int ldo;
    __device__ __forceinline__ void operator()(const Acc& acc, const Unit& u, int ui, int wr, int wc, int fr, int fq) const {
        const int row0 = u.pm * BM + wr * 64 + fr, col0 = u.pn * BM + wc * 32 + 8 * fq;
#pragma unroll
        for (int ai = 0; ai < 2; ++ai)
#pragma unroll
            for (int m = 0; m < 4; ++m) { bf16_t* rowp = O + (size_t)(row0 + ai * HALF + m * 16) * ldo + col0;
#pragma unroll
                for (int bj = 0; bj < 2; ++bj) *(u32x4*)(rowp + bj * HALF) = pack8(acc[ai][bj][m][0], acc[ai][bj][m][1]); }
    }
};
struct EpiEC {
    static constexpr bool PERM = false;
    bf16_t* assm; const float* a32;
    __device__ __forceinline__ void operator()(const Acc&, const Unit&, int, int, int, int, int) const {}
    __device__ __forceinline__ void fused(const Acc& acc, const Unit& u, int wr, int wc, int fr, int fq, LAS unsigned char* lds, int wid, int lane) const {
        LAS float* EL = (LAS float*)lds;
#pragma unroll
        for (int ai = 0; ai < 2; ++ai)
#pragma unroll
            for (int m = 0; m < 4; ++m) { const int rl = ai * HALF + wr * 64 + m * 16 + fr;
#pragma unroll
                for (int n = 0; n < 2; ++n) *(LAS f32x4*)(EL + rl * 128 + wc * 32 + n * 16 + 4 * fq) = acc[ai][0][m][n]; }
        __syncthreads();
        if (wid < 2) { const int g = u.pm >> 2, n = lane; const size_t arow0 = (size_t)u.pm * BM + wid * 128;
            const float ar = a32[(g * NS + n) * 2], ai_ = a32[(g * NS + n) * 2 + 1];
            float sr = 0.f, si = 0.f;
#pragma unroll 8
            for (int c = 0; c < NCH; ++c) { const float er = EL[(wid * 128 + c) * 128 + n], ei = EL[(wid * 128 + c) * 128 + 64 + n];
                assm[(arow0 + c) * KA + 512 + n] = (bf16_t)f2bf(sr); assm[(arow0 + c) * KA + 576 + n] = (bf16_t)f2bf(si);
                const float q = ar * sr - ai_ * si + er; si = ar * si + ai_ * sr + ei; sr = q; } }
        __syncthreads();
    }
};
struct EpiE {
    static constexpr bool PERM = false;
    float* E;
    __device__ __forceinline__ void operator()(const Acc& acc, const Unit& u, int ui, int wr, int wc, int fr, int fq) const {
        const int row0 = u.pm * BM + wr * 64 + fr, col0 = wc * 32 + 4 * fq;
#pragma unroll
        for (int ai = 0; ai < 2; ++ai)
#pragma unroll
            for (int m = 0; m < 4; ++m) { float* rowp = E + (size_t)(row0 + ai * HALF + m * 16) * 128 + col0;
#pragma unroll
                for (int n = 0; n < 2; ++n) *(f32x4*)(rowp + n * 16) = acc[ai][0][m][n]; }
    }
};
struct EpiY {
    static constexpr bool PERM = true;
    bf16_t* yg; const bf16_t* assm; const float* dskip;
    __device__ __forceinline__ void operator()(const Acc& acc, const Unit& u, int ui, int wr, int wc, int fr, int fq) const {
        const int g = u.pm >> 2, pnl = u.pn & 1;
        const int arow0 = u.pm * BM + wr * 64 + fr;
#pragma unroll
        for (int bj = 0; bj < 2; ++bj) {
            const int nloc = pnl * BM + bj * HALF + wc * 32 + 8 * fq, tl = nloc >> 4, h0 = nloc & 15;
            const f32x4 d0 = *(const f32x4*)(dskip + g * GH + h0), d1 = *(const f32x4*)(dskip + g * GH + h0 + 4);
            u32x4 uu[2][4];
#pragma unroll
            for (int ai = 0; ai < 2; ++ai)
#pragma unroll
                for (int m = 0; m < 4; ++m) uu[ai][m] = *(const u32x4*)(assm + (size_t)(arow0 + ai * HALF + m * 16) * KA + nloc);
#pragma unroll
            for (int ai = 0; ai < 2; ++ai)
#pragma unroll
                for (int m = 0; m < 4; ++m) { const int arow = arow0 + ai * HALF + m * 16, rl = arow - g * RPG;
                    f32x4 u0, u1; unpack8(uu[ai][m], u0, u1);
                    f32x4 v0 = acc[ai][bj][m][0] + d0 * u0, v1 = acc[ai][bj][m][1] + d1 * u1;
                    { const f32x2 g0 = gelu_pk((f32x2){v0[0], v0[1]}), g1 = gelu_pk((f32x2){v0[2], v0[3]}), g2 = gelu_pk((f32x2){v1[0], v1[1]}), g3 = gelu_pk((f32x2){v1[2], v1[3]});
                      v0 = (f32x4){g0.x, g0.y, g1.x, g1.y}; v1 = (f32x4){g2.x, g2.y, g3.x, g3.y}; }
                    *(u32x4*)(yg + (size_t)(rl * CL + tl) * SWID + g * GH + h0) = pack8(v0, v1); }
        }
    }
};
}

#define XB_TMO      128
#define XB_XCNT(j)  (256  + 64 * (j))
#define XB_XSUB(j)  (1280 + 64 * (j))
#define XB_XGEN(j)  (2304 + 64 * (j))
#define XB_TOP      3328
#define XB_TOPGEN   3392
#define XCD_BAR_WORDS 3456
#define XB_SPIN_CAP (1u << 22)
__device__ __forceinline__ unsigned xb_ld(unsigned* p)              { return __hip_atomic_load(p, __ATOMIC_RELAXED, __HIP_MEMORY_SCOPE_AGENT); }
__device__ __forceinline__ unsigned xb_add(unsigned* p, unsigned v) { return __hip_atomic_fetch_add(p, v, __ATOMIC_RELAXED, __HIP_MEMORY_SCOPE_AGENT); }
__device__ __forceinline__ unsigned xb_xcc_id() { return (unsigned)__builtin_amdgcn_s_getreg((3 << 11) | 20) & 0xFu; }
#define XB_SPIN(cond, bar) do { unsigned _sp = 0; while (cond) { __builtin_amdgcn_s_sleep(1); \
    if ((++_sp & 255u) == 0u) { if (xb_ld(&(bar)[XB_TMO])) break; if (_sp > XB_SPIN_CAP) { atomicAdd(&(bar)[XB_TMO], 1u); break; } } } } while (0)
struct XcdBarrier { unsigned* bar; unsigned x; volatile LAS unsigned* st; };
__device__ __forceinline__ XcdBarrier xcd_barrier_post(unsigned* bar, volatile LAS unsigned* st) {
    XcdBarrier b; b.bar = bar; b.x = xb_xcc_id(); b.st = st;
    if (threadIdx.x == 0) (void)xb_add(&bar[XB_XCNT(b.x)], 1u);
    return b;
}
__device__ __forceinline__ void xcd_barrier_complete(unsigned* bar, unsigned x, unsigned& nloc, unsigned& nx) {
    const unsigned G = gridDim.x * gridDim.y * gridDim.z;
    unsigned sum, cnt, mine, sp = 0u;
    for (;;) {
        sum = 0u; cnt = 0u; mine = 0u;
#pragma unroll
        for (unsigned j = 0; j < 16; ++j) { const unsigned c = xb_ld(&bar[XB_XCNT(j)]); sum += c; cnt += (c > 0u) ? 1u : 0u; mine = (j == x) ? c : mine; }
        if (sum == G) break;
        __builtin_amdgcn_s_sleep(1);
        if ((++sp & 255u) == 0u) { if (xb_ld(&bar[XB_TMO])) break; if (sp > XB_SPIN_CAP) { atomicAdd(&bar[XB_TMO], 1u); break; } }
    }
    nloc = mine > 0u ? mine : 1u; nx = cnt > 0u ? cnt : 1u;
}
__device__ __forceinline__ void xcd_barrier(const XcdBarrier& b) {
    asm volatile("s_waitcnt vmcnt(0)" ::: "memory");
    __syncthreads();
    if (threadIdx.x == 0) {
        unsigned* bar = b.bar;
        __builtin_amdgcn_s_waitcnt(0);
        unsigned nloc = b.st[0], nx = b.st[1];
        if (nloc == 0u) { xcd_barrier_complete(bar, b.x, nloc, nx); b.st[0] = nloc; b.st[1] = nx; }
        const unsigned old = xb_add(&bar[XB_XSUB(b.x)], 1u);
        const unsigned gen = old / nloc;
        if (old + 1u == (gen + 1u) * nloc) {
            __builtin_amdgcn_fence(__ATOMIC_RELEASE, "agent");
            asm volatile("s_waitcnt vmcnt(0)" ::: "memory");
            const unsigned og = xb_add(&bar[XB_TOP], 1u);
            const unsigned tg = og / nx;
            if (og + 1u == (tg + 1u) * nx) xb_add(&bar[XB_TOPGEN], 1u);
            else XB_SPIN(xb_ld(&bar[XB_TOPGEN]) == tg, bar);
            __builtin_amdgcn_fence(__ATOMIC_ACQUIRE, "agent");
            xb_add(&bar[XB_XGEN(b.x)], 1u);
            asm volatile("s_waitcnt vmcnt(0)" ::: "memory");
        } else {
            XB_SPIN(xb_ld(&bar[XB_XGEN(b.x)]) == gen, bar);
            __builtin_amdgcn_fence(__ATOMIC_ACQUIRE, "agent");
            asm volatile("s_waitcnt vmcnt(0)" ::: "memory");
        }
    }
    __syncthreads();
}

struct Args { const float* in[29]; float* out; unsigned char* ws; };

__device__ __forceinline__ void transpose_block(const float* __restrict__ W, int N, bf16_t* WT, int ldo, int k0, int n0, int orow0, LAS float* scr, int lane) {
    float t[32];
    const float* Wk = W + (size_t)k0 * N + n0;
    const unsigned lo = (unsigned)((lane >> 5) * N + (lane & 31));
#pragma unroll
    for (int i = 0; i < 32; ++i) t[i] = __builtin_nontemporal_load((Wk + (size_t)(2 * i) * N) + lo);
#pragma unroll
    for (int i = 0; i < 32; ++i) { const int kk = 2 * i + (lane >> 5); scr[kk * 33 + (lane & 31)] = t[i]; }
    LDS_WAIT();
    const int c = lane & 7;
#pragma unroll
    for (int j = 0; j < 4; ++j) { const int n = (lane >> 3) + 8 * j; const LAS float* s = scr + (8 * c) * 33 + n;
        u32x4 o; o.x = cvt_pk_bf16(s[0 * 33], s[1 * 33]); o.y = cvt_pk_bf16(s[2 * 33], s[3 * 33]); o.z = cvt_pk_bf16(s[4 * 33], s[5 * 33]); o.w = cvt_pk_bf16(s[6 * 33], s[7 * 33]);
        *(u32x4*)(WT + (size_t)(orow0 + n) * ldo + k0 + 8 * c) = o; }
    LDS_WAIT();
}
__device__ __forceinline__ void transpose_item(const float* W, int K, int N, bf16_t* WT, int nhalf, int item, LAS float* scr, int lane) {
    const int nblk = N / 32, kb = item / nblk, nb = item % nblk, k0 = 64 * kb, n0 = 32 * nb;
    int orow0 = n0;
    if (nhalf > 0) { const int h = n0 / nhalf, j = n0 % nhalf; orow0 = 256 * (j / 128) + 128 * h + (j % 128); }
    transpose_block(W, N, WT, K, k0, n0, orow0, scr, lane);
}

__device__ __forceinline__ void ssm_prep_stage1(const Args& a, int g, int sub, LAS float* L, int tid) {
    LAS float* PWR = L; LAS float* PWI = L + 2112; LAS float* BBR = L + 4224; LAS float* BBI = L + 5248; LAS float* CR = L + 6272; LAS float* CI = L + 7296;
    const float* lam_re_log = a.in[13]; const float* lam_im = a.in[14]; const float* log_dt = a.in[15];
    const float* b_re = a.in[16]; const float* b_im = a.in[17]; const float* c_re = a.in[18]; const float* c_im = a.in[19];
    bf16_t* BtY = (bf16_t*)(a.ws + WS_BTY); bf16_t* BtE = (bf16_t*)(a.ws + WS_BTE); float* A32 = (float*)(a.ws + WS_A32); float* KTg = (float*)(a.ws + WS_KT);
    if (tid < 64) {
        const int n = tid;
        const float lr = -expf(lam_re_log[g * NS + n]), li = lam_im[g * NS + n], dt = expf(log_dt[g]);
        const float mag = expf(lr * dt), ang = li * dt;
        const float abr = mag * cosf(ang), abi = mag * sinf(ang);
        const float nr = abr - 1.0f, ni = abi, den = lr * lr + li * li;
        const float fr = (nr * lr + ni * li) / den, fi = (ni * lr - nr * li) / den;
        float pr = 1.0f, pi = 0.0f;
        for (int tau = 0; tau <= CL; ++tau) { PWR[tau * NS + n] = pr; PWI[tau * NS + n] = pi; const float q = pr * abr - pi * abi; pi = pr * abi + pi * abr; pr = q; }
        if (sub == 0) { A32[(g * NS + n) * 2] = PWR[CL * NS + n]; A32[(g * NS + n) * 2 + 1] = PWI[CL * NS + n]; }
        for (int hp = 0; hp < GH; ++hp) { const float br = b_re[(g * NS + n) * GH + hp], bi = b_im[(g * NS + n) * GH + hp];
            BBR[n * GH + hp] = fr * br - fi * bi; BBI[n * GH + hp] = fr * bi + fi * br; }
    }
    for (int e = tid; e < GH * NS; e += 512) { CR[e] = c_re[g * GH * NS + e]; CI[e] = c_im[g * GH * NS + e]; }
    __syncthreads();
    for (int e = tid; e < 4 * GH * GH; e += 512) { const int tau = 4 * sub + (e >> 8), h = (e >> 4) & 15, hp = e & 15; float s = 0.f;
        for (int n = 0; n < NS; ++n) { const float pr = PWR[tau * NS + n], pi = PWI[tau * NS + n], br = BBR[n * GH + hp], bi = BBI[n * GH + hp];
            const float Pr = pr * br - pi * bi, Pi = pr * bi + pi * br; s += CR[h * NS + n] * Pr - CI[h * NS + n] * Pi; }
        KTg[(size_t)g * (CL * 256) + tau * 256 + (e & 255)] = s; }
    for (int q = tid; q < 64 * 16; q += 512) { const int row = 64 * sub + (q >> 4), ch = q & 15, t = row >> 4, h = row & 15, isim = ch >> 3, n0 = (ch & 7) * 8;
        float v[8];
#pragma unroll
        for (int j = 0; j < 8; ++j) { const int n = n0 + j; const float cr = CR[h * NS + n], ci = CI[h * NS + n], pr = PWR[(t + 1) * NS + n], pi = PWI[(t + 1) * NS + n];
            v[j] = isim ? -(cr * pi + ci * pr) : (cr * pr - ci * pi); }
        u32x4 o; o.x = cvt_pk_bf16(v[0], v[1]); o.y = cvt_pk_bf16(v[2], v[3]); o.z = cvt_pk_bf16(v[4], v[5]); o.w = cvt_pk_bf16(v[6], v[7]);
        *(u32x4*)(BtY + ((size_t)(g * 512 + row) * KA + 512 + isim * 64 + n0)) = o; }
    for (int q = tid; q < 32 * 64; q += 512) { const int row = 32 * sub + (q >> 6), ch = q & 63, s = ch >> 1, hp0 = (ch & 1) * 8;
        u32x4 o = (u32x4){0u, 0u, 0u, 0u};
        if (row < 128) { const int n = row & 63, isim = row >> 6; const float pr = PWR[(CL - 1 - s) * NS + n], pi = PWI[(CL - 1 - s) * NS + n];
            float v[8];
#pragma unroll
            for (int j = 0; j < 8; ++j) { const float br = BBR[n * GH + hp0 + j], bi = BBI[n * GH + hp0 + j]; v[j] = isim ? (pr * bi + pi * br) : (pr * br - pi * bi); }
            o.x = cvt_pk_bf16(v[0], v[1]); o.y = cvt_pk_bf16(v[2], v[3]); o.z = cvt_pk_bf16(v[4], v[5]); o.w = cvt_pk_bf16(v[6], v[7]); }
        *(u32x4*)(BtE + ((size_t)(g * 256 + row) * 512 + s * GH + hp0)) = o; }
    __syncthreads();
}

template <bool HASD, bool WRX, bool FINAL, bool XOUTB = false>
__device__ __forceinline__ void row_pass(const float* Xin, const bf16_t* delta, const float* gate0, float s, float* Xout, const float* gvec, const float* mod, int sub, bf16_t* Hout, int gw, int ngw, int lane) {
    for (int blk = gw; blk < M / 16; blk += ngw) {
        const int r0 = blk * 16, b = r0 / SEQ;
        f32x4 gs[4], sh[4], gt[4];
#pragma unroll
        for (int j = 0; j < 4; ++j) { const int c = 4 * lane + 256 * j; const f32x4 gg = *(const f32x4*)(gvec + c);
            if (FINAL) { gs[j] = gg; sh[j] = (f32x4){0.f, 0.f, 0.f, 0.f}; }
            else { const float* shift = mod + (size_t)b * NMODC + (sub * 3 + 0) * D; gs[j] = gg * (*(const f32x4*)(shift + D + c) + 1.0f); sh[j] = *(const f32x4*)(shift + c); }
            if (HASD) gt[j] = *(const f32x4*)(gate0 + (size_t)b * NMODC + c) * s; }
        f32x4 v[4], nx[4], nx2[4]; u32x2 dl[4], nd[4], nd2[4];
        { const f32x4* xr = (const f32x4*)(Xin + (size_t)r0 * D) + lane; const u32x2* dr = (const u32x2*)(delta + (size_t)r0 * D) + lane;
#pragma unroll
          for (int j = 0; j < 4; ++j) { v[j] = __builtin_nontemporal_load(xr + 64 * j); if (HASD) dl[j] = __builtin_nontemporal_load(dr + 64 * j); }
#pragma unroll
          for (int j = 0; j < 4; ++j) { nx[j] = __builtin_nontemporal_load(xr + 64 * j + D / 4); if (HASD) nd[j] = __builtin_nontemporal_load(dr + 64 * j + D / 4); } }
        for (int r = r0; r < r0 + 16; ++r) {
            if (r + 2 < r0 + 16) { const f32x4* xr = (const f32x4*)(Xin + (size_t)(r + 2) * D) + lane; const u32x2* dr = (const u32x2*)(delta + (size_t)(r + 2) * D) + lane;
#pragma unroll
                for (int j = 0; j < 4; ++j) { nx2[j] = __builtin_nontemporal_load(xr + 64 * j); if (HASD) nd2[j] = __builtin_nontemporal_load(dr + 64 * j); } }
            float ss = 0.f;
#pragma unroll
            for (int j = 0; j < 4; ++j) {
                if (HASD) { const f32x4 d = (f32x4){bflo(dl[j].x), bfhi(dl[j].x), bflo(dl[j].y), bfhi(dl[j].y)}; v[j] += gt[j] * d; }
                ss += (v[j].x * v[j].x + v[j].y * v[j].y) + (v[j].z * v[j].z + v[j].w * v[j].w); }
            const float rstd = 1.0f / sqrtf(wave_sum(ss) * (1.0f / D) + EPS);
            if (FINAL) { f32x4* xo = (f32x4*)(Xout + (size_t)r * D) + lane;
#pragma unroll
                for (int j = 0; j < 4; ++j) __builtin_nontemporal_store(v[j] * rstd * gs[j], xo + 64 * j); }
            else {
                if (WRX && !XOUTB) { f32x4* xo = (f32x4*)(Xout + (size_t)r * D) + lane;
#pragma unroll
                    for (int j = 0; j < 4; ++j) __builtin_nontemporal_store(v[j], xo + 64 * j); }
                if (WRX && XOUTB) { u32x2* xo = (u32x2*)((bf16_t*)Xout + (size_t)r * D) + lane;
#pragma unroll
                    for (int j = 0; j < 4; ++j) { u32x2 w; w.x = cvt_pk_bf16(v[j].x, v[j].y); w.y = cvt_pk_bf16(v[j].z, v[j].w); __builtin_nontemporal_store(w, xo + 64 * j); } }
                u32x2* o8 = (u32x2*)(Hout + (size_t)r * D) + lane;
#pragma unroll
                for (int j = 0; j < 4; ++j) { const f32x4 o = v[j] * rstd * gs[j] + sh[j]; u32x2 w; w.x = cvt_pk_bf16(o.x, o.y); w.y = cvt_pk_bf16(o.z, o.w); o8[64 * j] = w; } }
#pragma unroll
            for (int j = 0; j < 4; ++j) { v[j] = nx[j]; nx[j] = nx2[j]; if (HASD) { dl[j] = nd[j]; nd[j] = nd2[j]; } }
        }
    }
}

__device__ __forceinline__ void norm_mod_phase(const float* X, const float* gvec, const float* mod, int sub, bf16_t* Hout, int gw, int ngw, int lane) {
    for (int blk = gw; blk < M / 16; blk += ngw) {
        const int r0 = blk * 16, b = r0 / SEQ;
        const float* shift = mod + (size_t)b * NMODC + (sub * 3 + 0) * D; const float* scale = shift + D;
        f32x4 gs[4], sh[4];
#pragma unroll
        for (int j = 0; j < 4; ++j) { const int c = 4 * lane + 256 * j; const f32x4 gg = *(const f32x4*)(gvec + c), sc = *(const f32x4*)(scale + c); gs[j] = gg * (sc + 1.0f); sh[j] = *(const f32x4*)(shift + c); }
        f32x4 v[4], nx[4];
        { const f32x4* xr = (const f32x4*)(X + (size_t)r0 * D) + lane;
#pragma unroll
          for (int j = 0; j < 4; ++j) v[j] = xr[64 * j]; }
        for (int r = r0; r < r0 + 16; ++r) {
            if (r + 1 < r0 + 16) { const f32x4* xr = (const f32x4*)(X + (size_t)(r + 1) * D) + lane;
#pragma unroll
                for (int j = 0; j < 4; ++j) nx[j] = xr[64 * j]; }
            float s = 0.f;
#pragma unroll
            for (int j = 0; j < 4; ++j) s += (v[j].x * v[j].x + v[j].y * v[j].y) + (v[j].z * v[j].z + v[j].w * v[j].w);
            const float rstd = 1.0f / sqrtf(wave_sum(s) * (1.0f / D) + EPS);
            u32x2* o8 = (u32x2*)(Hout + (size_t)r * D) + lane;
#pragma unroll
            for (int j = 0; j < 4; ++j) { const f32x4 o = v[j] * rstd * gs[j] + sh[j]; u32x2 w; w.x = cvt_pk_bf16(o.x, o.y); w.y = cvt_pk_bf16(o.z, o.w); o8[64 * j] = w; }
#pragma unroll
            for (int j = 0; j < 4; ++j) v[j] = nx[j];
        }
    }
}

__device__ __forceinline__ void resid_xg_pass(const float* Xin, const bf16_t* delta, const float* gate0, float s, float* Xout, const float* gvec, const float* mod, int sub, bf16_t* Hout, float* rss, int gw, int ngw, int lane) {
    for (int blk = gw; blk < M / 16; blk += ngw) {
        const int r0 = blk * 16, b = r0 / SEQ;
        f32x4 gs[4], gt[4];
#pragma unroll
        for (int j = 0; j < 4; ++j) { const int c = 4 * lane + 256 * j; const float* shift = mod + (size_t)b * NMODC + (sub * 3 + 0) * D;
            gs[j] = *(const f32x4*)(gvec + c) * (*(const f32x4*)(shift + D + c) + 1.0f); gt[j] = *(const f32x4*)(gate0 + (size_t)b * NMODC + c) * s; }
        f32x4 v[4], nx[4], nx2[4]; u32x2 dl[4], nd[4], nd2[4];
        { const f32x4* xr = (const f32x4*)(Xin + (size_t)r0 * D) + lane; const u32x2* dr = (const u32x2*)(delta + (size_t)r0 * D) + lane;
#pragma unroll
          for (int j = 0; j < 4; ++j) { v[j] = __builtin_nontemporal_load(xr + 64 * j); dl[j] = __builtin_nontemporal_load(dr + 64 * j); }
#pragma unroll
          for (int j = 0; j < 4; ++j) { nx[j] = __builtin_nontemporal_load(xr + 64 * j + D / 4); nd[j] = __builtin_nontemporal_load(dr + 64 * j + D / 4); } }
        for (int r = r0; r < r0 + 16; ++r) {
            if (r + 2 < r0 + 16) { const f32x4* xr = (const f32x4*)(Xin + (size_t)(r + 2) * D) + lane; const u32x2* dr = (const u32x2*)(delta + (size_t)(r + 2) * D) + lane;
#pragma unroll
                for (int j = 0; j < 4; ++j) { nx2[j] = __builtin_nontemporal_load(xr + 64 * j); nd2[j] = __builtin_nontemporal_load(dr + 64 * j); } }
            float ss = 0.f;
#pragma unroll
            for (int j = 0; j < 4; ++j) { const f32x4 d = (f32x4){bflo(dl[j].x), bfhi(dl[j].x), bflo(dl[j].y), bfhi(dl[j].y)}; v[j] += gt[j] * d;
                ss += (v[j].x * v[j].x + v[j].y * v[j].y) + (v[j].z * v[j].z + v[j].w * v[j].w); }
            ss = wave_sum(ss);
            if (lane < 16) rss[(size_t)r * 16 + lane] = (lane == 0) ? ss : 0.f;
            f32x4* xo = (f32x4*)(Xout + (size_t)r * D) + lane; u32x2* o8 = (u32x2*)(Hout + (size_t)r * D) + lane;
#pragma unroll
            for (int j = 0; j < 4; ++j) { __builtin_nontemporal_store(v[j], xo + 64 * j); const f32x4 o = v[j] * gs[j]; u32x2 w; w.x = cvt_pk_bf16(o.x, o.y); w.y = cvt_pk_bf16(o.z, o.w); o8[64 * j] = w; }
#pragma unroll
            for (int j = 0; j < 4; ++j) { v[j] = nx[j]; nx[j] = nx2[j]; dl[j] = nd[j]; nd[j] = nd2[j]; }
        }
    }
}

template <int W> __device__ __forceinline__ void zpass_group(const bf16_t* UP, bf16_t* Z, int tb, int k, int lane) {
    const int cl = lane & 15, tq = lane >> 4;
    const int t0 = tb * 16 + tq * 4, tin = t0 & (SEQ - 1), c0 = k * 128 + cl * 8;
    constexpr int NR = W + 3;
    u32x4 rows[NR];
#pragma unroll
    for (int j = 0; j < NR; ++j) { const int dt = j - (W - 1);
        rows[j] = (tin + dt >= 0) ? *(const u32x4*)(UP + (size_t)(t0 + dt) * PWID + c0) : (u32x4){0u, 0u, 0u, 0u}; }
    f32x4 s0 = (f32x4){0.f, 0.f, 0.f, 0.f}, s1 = s0;
#pragma unroll
    for (int j = 0; j < W; ++j) { f32x4 a0, a1; pg8::unpack8(rows[j], a0, a1); s0 += a0; s1 += a1; }
#pragma unroll
    for (int i = 0; i < 4; ++i) {
        f32x4 c0v, c1v; pg8::unpack8(rows[W - 1 + i], c0v, c1v);
        if (i > 0) { f32x4 o0, o1; pg8::unpack8(rows[i - 1], o0, o1); s0 += c0v - o0; s1 += c1v - o1; }
        const int cnt = (tin + i + 1 < W) ? (tin + i + 1) : W; const float inv = 1.0f / (float)cnt;
        *(u32x4*)(Z + (size_t)(t0 + i) * PWID + c0) = pg8::pack8(s0 * inv - c0v, s1 * inv - c1v);
    }
}

__device__ __forceinline__ void final_pass_bf16x(const bf16_t* Xb, const bf16_t* delta, const float* gate0, float s, float* out, const float* gvec, int blk, int lane) {
    const int r0 = blk * 16, b = r0 / SEQ;
    f32x4 gs[4], gt[4];
#pragma unroll
    for (int j = 0; j < 4; ++j) { const int c = 4 * lane + 256 * j; gs[j] = *(const f32x4*)(gvec + c); gt[j] = *(const f32x4*)(gate0 + (size_t)b * NMODC + c) * s; }
    u32x2 xa[4], xn1[4], xn2[4], da[4], dn1[4], dn2[4];
    { const u32x2* xr = (const u32x2*)(Xb + (size_t)r0 * D) + lane; const u32x2* dr = (const u32x2*)(delta + (size_t)r0 * D) + lane;
#pragma unroll
      for (int j = 0; j < 4; ++j) { xa[j] = __builtin_nontemporal_load(xr + 64 * j); da[j] = __builtin_nontemporal_load(dr + 64 * j); }
#pragma unroll
      for (int j = 0; j < 4; ++j) { xn1[j] = __builtin_nontemporal_load(xr + 64 * j + D / 4); dn1[j] = __builtin_nontemporal_load(dr + 64 * j + D / 4); } }
    for (int r = r0; r < r0 + 16; ++r) {
        if (r + 2 < r0 + 16) { const u32x2* xr = (const u32x2*)(Xb + (size_t)(r + 2) * D) + lane; const u32x2* dr = (const u32x2*)(delta + (size_t)(r + 2) * D) + lane;
#pragma unroll
            for (int j = 0; j < 4; ++j) { xn2[j] = __builtin_nontemporal_load(xr + 64 * j); dn2[j] = __builtin_nontemporal_load(dr + 64 * j); } }
        f32x4 v[4]; float ss = 0.f;
#pragma unroll
        for (int j = 0; j < 4; ++j) { const f32x4 x = (f32x4){bflo(xa[j].x), bfhi(xa[j].x), bflo(xa[j].y), bfhi(xa[j].y)}, d = (f32x4){bflo(da[j].x), bfhi(da[j].x), bflo(da[j].y), bfhi(da[j].y)};
            v[j] = x + gt[j] * d; ss += (v[j].x * v[j].x + v[j].y * v[j].y) + (v[j].z * v[j].z + v[j].w * v[j].w); }
        const float rstd = 1.0f / sqrtf(wave_sum(ss) * (1.0f / D) + EPS);
        f32x4* xo = (f32x4*)(out + (size_t)r * D) + lane;
#pragma unroll
        for (int j = 0; j < 4; ++j) __builtin_nontemporal_store(v[j] * rstd * gs[j], xo + 64 * j);
#pragma unroll
        for (int j = 0; j < 4; ++j) { xa[j] = xn1[j]; xn1[j] = xn2[j]; da[j] = dn1[j]; dn1[j] = dn2[j]; }
    }
}

constexpr int LDS_BYTES = 163840;
constexpr int LDS_RSTD = 131072 + 1024, LDS_SWT = LDS_RSTD + 11 * 1024, MAXU = 11;
template <class Sched> __device__ __forceinline__ void fill_norm_tables(LAS unsigned char* lds, const Sched& S, const float* rss, const float* sW, int nw, int tid) {
    LAS float* rstdL = (LAS float*)(lds + LDS_RSTD); LAS float* swL = (LAS float*)(lds + LDS_SWT);
    constexpr int NU = 6;
    pg8::Unit u[NU]; bool ok[NU]; f32x4 q[NU]; float sv[NU];
#pragma unroll
    for (int ui = 0; ui < NU; ++ui) { ok[ui] = S.next(ui, u[ui]); q[ui] = (f32x4){0.f, 0.f, 0.f, 0.f}; sv[ui] = 0.f;
        if (ok[ui]) { if (tid < 256) { const f32x4* p = (const f32x4*)(rss + (size_t)(u[ui].pm * 256 + tid) * 16); q[ui] = (p[0] + p[1]) + (p[2] + p[3]); }
                      else sv[ui] = sW[(size_t)(u[ui].pm >> 4) * nw + u[ui].pn * 256 + tid - 256]; } }
#pragma unroll
    for (int ui = 0; ui < NU; ++ui) if (ok[ui]) { if (tid < 256) rstdL[ui * 256 + tid] = 1.0f / sqrtf(((q[ui].x + q[ui].y) + (q[ui].z + q[ui].w)) * (1.0f / D) + EPS); else swL[ui * 256 + tid - 256] = sv[ui]; }
    __syncthreads();
}

__global__ void __launch_bounds__(512, 2) mega_fwd(Args a) {
    extern __shared__ __attribute__((aligned(16))) unsigned char lds_raw[];
    LAS unsigned char* lds = (LAS unsigned char*)lds_raw;
    cg::grid_group grid = cg::this_grid();
    const int G = gridDim.x, bid = blockIdx.x, ngw = G * 8;
#define PHASE_IDS int tid = threadIdx.x; asm volatile("" : "+v"(tid)); const int lane = tid & 63, wave = __builtin_amdgcn_readfirstlane(tid >> 6), gw = bid * 8 + wave; \
    LAS float* scr = (LAS float*)(lds + wave * 16384); (void)lane; (void)gw; (void)scr;
#define x_in (a.in[0])
#define X (a.out)
#define mod ((float*)(a.ws + WS_MOD))
#define part ((float*)(a.ws + WS_PART))
#define W1IN ((bf16_t*)(a.ws + WS_W1IN))
#define W1OUT ((bf16_t*)(a.ws + WS_W1OUT))
#define WIN ((bf16_t*)(a.ws + WS_WIN))
#define WPOOL ((bf16_t*)(a.ws + WS_WPOOL))
#define WPUP ((bf16_t*)(a.ws + WS_WPUP))
#define WGLU ((bf16_t*)(a.ws + WS_WGLU))
#define WSUP ((bf16_t*)(a.ws + WS_WSUP))
#define WOUT ((bf16_t*)(a.ws + WS_WOUT))
#define W2IN ((bf16_t*)(a.ws + WS_W2IN))
#define W2OUT ((bf16_t*)(a.ws + WS_W2OUT))
#define BTE ((bf16_t*)(a.ws + WS_BTE))
#define BTY ((bf16_t*)(a.ws + WS_BTY))
#define Hb ((bf16_t*)(a.ws + WS_H))
#define ACT ((bf16_t*)(a.ws + WS_ACT))
#define UPOOL ((bf16_t*)(a.ws + WS_UPOOL))
#define ASSM ((bf16_t*)(a.ws + WS_ASSM))
#define Zb ((bf16_t*)(a.ws + WS_Z))
#define ZP ((bf16_t*)(a.ws + WS_ZP))
#define Eb ((float*)(a.ws + WS_E))
#define YG ((bf16_t*)(a.ws + WS_YG))
#define SG ((bf16_t*)(a.ws + WS_SG))
#define SIGP ((bf16_t*)(a.ws + WS_SIGP))
#define SIGS ((bf16_t*)(a.ws + WS_SIGS))
#define MERGED Hb
#define DELTA SIGP
#define RSS ((float*)(a.ws + WS_RSS))
#define SWIN ((float*)(a.ws + WS_SW))
#define SW2 (SWIN + BATCH * 3072)
    volatile LAS unsigned* MISC = (volatile LAS unsigned*)(lds + 131072 + 320);
    if (threadIdx.x < 16) MISC[threadIdx.x] = 0u;
    __syncthreads();
    const XcdBarrier xbar = xcd_barrier_post((unsigned*)(a.ws + WS_BAR), MISC + 8);
#define GRID_BAR() xcd_barrier(xbar)

    { PHASE_IDS
    for (int w = bid; w < NG * 8; w += G) ssm_prep_stage1(a, w >> 3, w & 7, (LAS float*)lds, tid);
    {
        const float* cvec = a.in[1]; const float* w_ada = a.in[2];
        for (int it = bid + G * wave; it < MODKC * 36 && wave < 3; it += 3 * G) {
            const int kc = it / 36, cb = it % 36;
#pragma unroll
            for (int b = 0; b < BATCH; ++b) { const float v = cvec[b * D + kc * 64 + lane]; scr[b * 64 + lane] = v * sigm(v); }
            LDS_WAIT();
            f32x4 acc[BATCH];
#pragma unroll
            for (int b = 0; b < BATCH; ++b) acc[b] = (f32x4){0.f, 0.f, 0.f, 0.f};
            const float* wp = w_ada + (size_t)(kc * 64) * NMODC + cb * 256;
            const unsigned lo4 = (unsigned)lane * 4u;
#pragma unroll 8
            for (int k = 0; k < 64; ++k) { const f32x4 w = __builtin_nontemporal_load((const f32x4*)((wp + (size_t)k * NMODC) + lo4));
#pragma unroll
                for (int b = 0; b < BATCH; ++b) acc[b] += w * scr[b * 64 + k]; }
#pragma unroll
            for (int b = 0; b < BATCH; ++b) *(f32x4*)(part + (size_t)(kc * BATCH + b) * NMODC + cb * 256 + lane * 4) = acc[b];
            LDS_WAIT();
        }
    }
    {
        constexpr int I1 = (D / 64) * (2 * FF / 32), I2 = (FF / 64) * (D / 32), I3 = (D / 64) * (3072 / 32), I4 = 4 * 2 * 4, I5 = (512 / 64) * (D / 32), I8 = (D / 64) * (D / 32);
        constexpr int NIT = 2 * I1 + 2 * I2 + I3 + I4 + 3 * I5 + I8;
        const int nmod = (bid + 2 * G < MODKC * 36) ? 3 : ((bid + G < MODKC * 36) ? 2 : ((bid < MODKC * 36) ? 1 : 0));
        const int nper = (NIT - bid + G - 1) / G;
        const int J1 = (nmod >= 8) ? 0 : ((nper * (8 - nmod) * 13) / (8 * 13 - nmod * 8) < nper ? (nper * (8 - nmod) * 13) / (8 * 13 - nmod * 8) : nper);
        const bool ismod = wave < nmod;
        const int jstart = ismod ? J1 + wave : wave - nmod, jstep = ismod ? nmod : 8 - nmod, jend = ismod ? nper : J1;
        for (int j = jstart; j < jend; j += jstep) {
            const int it = bid + G * j;
            int r = it;
            if (r < I1) { transpose_item(a.in[5], D, 2 * FF, W1IN, FF, r, scr, lane); continue; } r -= I1;
            if (r < I1) { transpose_item(a.in[26], D, 2 * FF, W2IN, FF, r, scr, lane); continue; } r -= I1;
            if (r < I2) { transpose_item(a.in[6], FF, D, W1OUT, 0, r, scr, lane); continue; } r -= I2;
            if (r < I2) { transpose_item(a.in[27], FF, D, W2OUT, 0, r, scr, lane); continue; } r -= I2;
            if (r < I3) { transpose_item(a.in[8], D, 3072, WIN, 0, r, scr, lane); continue; } r -= I3;
            if (r < I4) { const int k = r >> 3, q = r & 7, kb = q >> 2, nb = q & 3;
                transpose_block(a.in[9] + (size_t)k * 128 * 128, 128, WPOOL + (size_t)(k * 128) * PWID + k * 128, PWID, 64 * kb, 32 * nb, 32 * nb, scr, lane); continue; } r -= I4;
            if (r < I5) { transpose_item(a.in[12], 512, D, WPUP, 0, r, scr, lane); continue; } r -= I5;
            if (r < I5) { transpose_item(a.in[21], 512, D, WGLU, 512, r, scr, lane); continue; } r -= I5;
            if (r < I5) { transpose_item(a.in[23], 512, D, WSUP, 0, r, scr, lane); continue; } r -= I5;
            transpose_item(a.in[24], D, D, WOUT, 0, r, scr, lane);
        }
        for (int q = bid * 512 + tid; q < 12 * 128 * 16; q += G * 512) { const int blk = q / 2048, rem = q % 2048, row = rem >> 4, ch = rem & 15;
            const int kr = blk / 3, kk = blk % 3, kc = kk + (kk >= kr ? 1 : 0);
            *(u32x4*)(WPOOL + (size_t)(kr * 128 + row) * PWID + kc * 128 + ch * 8) = (u32x4){0u, 0u, 0u, 0u}; }
    }
    }
    if (a.ws == nullptr) grid.sync();
    GRID_BAR();
    { PHASE_IDS
        const float* b_ada = a.in[3];
        {
            const int bb = bid >> 5;
            for (int i = tid; i < 2 * D; i += 512) { float s = b_ada[i];
#pragma unroll
                for (int kc = 0; kc < MODKC; ++kc) s += part[(size_t)(kc * BATCH + bb) * NMODC + i];
                mod[(size_t)bb * NMODC + i] = s; }
            for (int i = bid * 512 + tid; i < BATCH * NMODC; i += G * 512) { float s = b_ada[i % NMODC];
#pragma unroll
                for (int kc = 0; kc < MODKC; ++kc) s += part[(size_t)kc * BATCH * NMODC + i];
                mod[i] = s; }
            asm volatile("s_waitcnt vmcnt(0)" ::: "memory"); __syncthreads();
        }
        row_pass<false, false, false>(x_in, Hb, mod, 0.f, X, a.in[4], mod, 0, Hb, gw, ngw, lane);
        const float* KTg = (const float*)(a.ws + WS_KT);
        for (int q0 = bid * 512 + tid; q0 < NG * 512 * 64; q0 += 4 * G * 512) {
            f32x4 k0[4], k1[4];
#pragma unroll
            for (int e = 0; e < 4; ++e) { const int q = q0 + e * G * 512, g = q >> 15, row = (q >> 6) & 511, ch = q & 63, t = row >> 4, h = row & 15, s = ch >> 1, hp0 = (ch & 1) * 8;
                k0[e] = (f32x4){0.f, 0.f, 0.f, 0.f}; k1[e] = k0[e];
                if (t >= s) { const float* kp = KTg + (size_t)g * (CL * 256) + (t - s) * 256 + h * 16 + hp0; k0[e] = *(const f32x4*)kp; k1[e] = *(const f32x4*)(kp + 4); } }
#pragma unroll
            for (int e = 0; e < 4; ++e) { const int q = q0 + e * G * 512, g = q >> 15, row = (q >> 6) & 511, ch = q & 63, s = ch >> 1, hp0 = (ch & 1) * 8;
                *(u32x4*)(BTY + ((size_t)(g * 512 + row) * KA + s * GH + hp0)) = pg8::pack8(k0[e], k1[e]); } }
    }
    GRID_BAR();
    {
        pg8::Gemm g{Hb, W1IN, D, D, D, 0}; pg8::StaticOrder S; S.init(M, 2 * FF, G, bid);
        pg8::EpiSwiGLU<false> E{ACT, FF, nullptr, nullptr};
        pg8::gemm_phase<pg8::EpiSwiGLU<false>, pg8::StaticOrder, true>(lds, g, S, E);
    }
    GRID_BAR();
    {
        pg8::Gemm g{ACT, W1OUT, FF, FF, FF, 0}; pg8::StaticOrder S; S.init(M, D, G, bid);
        pg8::EpiPlain E{DELTA, D};
        pg8::gemm_phase<pg8::EpiPlain, pg8::StaticOrder, true>(lds, g, S, E);
    }
    GRID_BAR();
    { PHASE_IDS
    {
        for (int row = gw; row < 3072; row += ngw) {
            const bf16_t* wrow = WIN + (size_t)row * D;
            f32x4 w[4]; { f32x4 t0, t1; pg8::unpack8(*(const u32x4*)(wrow + 8 * lane), t0, t1); w[0] = t0; w[1] = t1; pg8::unpack8(*(const u32x4*)(wrow + 512 + 8 * lane), t0, t1); w[2] = t0; w[3] = t1; }
            f32x4 sh4[BATCH][4];
#pragma unroll
            for (int b = 0; b < BATCH; ++b) { const float* sh = mod + (size_t)b * NMODC + (1 * 3 + 0) * D;
                sh4[b][0] = *(const f32x4*)(sh + 8 * lane); sh4[b][1] = *(const f32x4*)(sh + 8 * lane + 4); sh4[b][2] = *(const f32x4*)(sh + 512 + 8 * lane); sh4[b][3] = *(const f32x4*)(sh + 512 + 8 * lane + 4); }
#pragma unroll
            for (int b = 0; b < BATCH; ++b) { const f32x4 pr = (w[0] * sh4[b][0] + w[1] * sh4[b][1]) + (w[2] * sh4[b][2] + w[3] * sh4[b][3]);
                const float tot = wave_sum((pr.x + pr.y) + (pr.z + pr.w));
                if (lane == 0) SWIN[(size_t)b * 3072 + row] = tot; }
        }
    }
    resid_xg_pass(x_in, DELTA, mod + (0 * 3 + 2) * D, 0.5f, X, a.in[7], mod, 1, Hb, RSS, (bid & 7) * 256 + (bid >> 3) * 8 + wave, ngw, lane);
    }
    GRID_BAR();
    {
        pg8::Gemm g{Hb, WIN, D, D, D, 0}; pg8::StaticOrder S; S.init(M, 3072, G, bid);
        { PHASE_IDS fill_norm_tables(lds, S, RSS, SWIN, 3072, tid); }
        pg8::EpiWin E{UPOOL, ASSM, SIGP, SIGS, (const LAS float*)(lds + LDS_RSTD), (const LAS float*)(lds + LDS_SWT)};
        pg8::gemm_phase<pg8::EpiWin, pg8::StaticOrder, true>(lds, g, S, E);
    }
    GRID_BAR();
    {
        { PHASE_IDS
        const int slot = bid >> 3; const bool split = (G == 256);
        const int zw = split ? ((slot - 16) * 8 + (bid & 7)) * 8 + wave : gw, nzw = split ? 1024 : ngw;
        if (!split || slot >= 16)
            for (int tb = zw; tb < M / 16; tb += nzw) { zpass_group<2>(UPOOL, Zb, tb, 0, lane); zpass_group<4>(UPOOL, Zb, tb, 1, lane); zpass_group<8>(UPOOL, Zb, tb, 2, lane); zpass_group<16>(UPOOL, Zb, tb, 3, lane); } }
        pg8::Gemm g{ASSM, BTE, KA, 512, 512, 0}; pg8::OrderE S{G, bid};
        pg8::EpiEC E{ASSM, (const float*)(a.ws + WS_A32)};
        pg8::gemm_phase<pg8::EpiEC, pg8::OrderE, false>(lds, g, S, E);
    }
    GRID_BAR();
    {
        pg8::Gemm g{Zb, WPOOL, PWID, PWID, 256, 256 * 2};     pg8::StaticOrder S; S.init(M, PWID, G, bid);
        pg8::EpiPool1 E{ZP, a.in[10], a.in[11]};
        pg8::gemm_phase<pg8::EpiPool1, pg8::StaticOrder, false>(lds, g, S, E);
    }
    GRID_BAR();
    {
        { pg8::Gemm g{ASSM, BTY, KA, KA, KA, 0}; pg8::OrderY S{G, bid}; pg8::EpiY E{YG, ASSM, a.in[20]};
          pg8::gemm_phase<pg8::EpiY, pg8::OrderY, false>(lds, g, S, E); }
        { pg8::Gemm g{ZP, WPUP, PWID, PWID, PWID, 0}; pg8::StaticOrder S; S.init(M, D, G, bid); pg8::EpiGateAcc<false> E{MERGED, SIGP};
          pg8::gemm_phase<pg8::EpiGateAcc<false>, pg8::StaticOrder, true>(lds, g, S, E); }
    }
    GRID_BAR();
    {
        pg8::Gemm g{YG, WGLU, SWID, SWID, SWID, 0}; pg8::StaticOrder S; S.init(M, 2 * SWID, G, bid);
        pg8::EpiGLU E{SG, SWID, a.in[22], SWID};
        pg8::gemm_phase<pg8::EpiGLU, pg8::StaticOrder, true>(lds, g, S, E);
    }
    GRID_BAR();
    {
        pg8::Gemm g{SG, WSUP, SWID, SWID, SWID, 0}; pg8::StaticOrder S; S.init(M, D, G, bid);
        pg8::EpiGateAcc<true> E{MERGED, SIGS};
        pg8::gemm_phase<pg8::EpiGateAcc<true>, pg8::StaticOrder, true>(lds, g, S, E);
    }
    GRID_BAR();
    {
        pg8::Gemm g{MERGED, WOUT, D, D, D, 0}; pg8::StaticOrder S; S.init(M, D, G, bid);
        pg8::EpiPlain E{DELTA, D};
        pg8::gemm_phase<pg8::EpiPlain, pg8::StaticOrder, true>(lds, g, S, E);
    }
    GRID_BAR();
    { PHASE_IDS
    row_pass<true, true, false, true>(X, DELTA, mod + (1 * 3 + 2) * D, 1.0f, (float*)SIGS  , a.in[25], mod, 2, Hb, (bid & 7) * 256 + (bid >> 3) * 8 + wave, ngw, lane);
    }
    GRID_BAR();
    {
        pg8::Gemm g{Hb, W2IN, D, D, D, 0}; pg8::StaticOrder S; S.init(M, 2 * FF, G, bid);
        pg8::EpiSwiGLU<false> E{ACT, FF, nullptr, nullptr};
        pg8::gemm_phase<pg8::EpiSwiGLU<false>, pg8::StaticOrder, true>(lds, g, S, E);
    }
    GRID_BAR();
    {
        pg8::Gemm g{ACT, W2OUT, FF, FF, FF, 0}; pg8::StaticOrder S; S.init(M, D, G, bid);
        pg8::EpiPlain E{DELTA, D};
        pg8::gemm_phase<pg8::EpiPlain, pg8::StaticOrder, true>(lds, g, S, E);
    }
    GRID_BAR();
    { PHASE_IDS
    final_pass_bf16x(SIGS, DELTA, mod + (2 * 3 + 2) * D, 0.5f, X, a.in[28], (bid & 7) * 256 + (bid >> 3) * 8 + wave, lane);
    }
}

extern "C" void kernel_launch(void* const* d_in, const int* in_sizes, int n_in, void* d_out, int out_size, void* d_ws, size_t ws_size, hipStream_t stream) {
    static int grid_blocks = 0;
    if (grid_blocks == 0) {
        if (n_in != 29 || out_size != M * D || ws_size < WS_END) { fprintf(stderr, "kernel_launch: unexpected problem (n_in %d out %d ws %zu)\n", n_in, out_size, ws_size); grid_blocks = -1; return; }
        int dev = 0, cus = 0, per_cu = 0;
        (void)hipGetDevice(&dev);
        (void)hipDeviceGetAttribute(&cus, hipDeviceAttributeMultiprocessorCount, dev);
        (void)hipFuncSetAttribute((const void*)mega_fwd, hipFuncAttributeMaxDynamicSharedMemorySize, LDS_BYTES);
        (void)hipOccupancyMaxActiveBlocksPerMultiprocessor(&per_cu, (const void*)mega_fwd, 512, LDS_BYTES);
        (void)hipGetLastError();
        if (per_cu < 1) per_cu = 1;
        grid_blocks = cus * per_cu;
        if (grid_blocks != 256) { fprintf(stderr, "kernel_launch: built for a 256-workgroup grid (got %d)\n", grid_blocks); grid_blocks = -1; return; }
    }
    if (grid_blocks < 0) return;
    Args a{};
    for (int i = 0; i < 29; ++i) a.in[i] = (const float*)d_in[i];
    a.out = (float*)d_out; a.ws = (unsigned char*)d_ws;
    (void)hipMemsetAsync((unsigned char*)d_ws + WS_BAR, 0, BAR_BYTES, stream);
    void* args[] = {&a};
    hipError_t e = hipLaunchCooperativeKernel((const void*)mega_fwd, dim3(grid_blocks), dim3(512), args, LDS_BYTES, stream);
    if (e != hipSuccess) fprintf(stderr, "cooperative launch failed: %s (grid %d)\n", hipGetErrorString(e), grid_blocks);
}
```

```cpp
#include <hip/hip_runtime.h>
#include <hip/hip_cooperative_groups.h>
#include <cstdio>
namespace cg = cooperative_groups;

#define LAS __attribute__((address_space(3)))
typedef unsigned short bf16_t;
typedef short bf16x8 __attribute__((ext_vector_type(8)));
typedef float f32x4 __attribute__((ext_vector_type(4)));
typedef unsigned u32x4 __attribute__((ext_vector_type(4)));
typedef unsigned u32x2 __attribute__((ext_vector_type(2)));

constexpr int D = 1024, BATCH = 8, SEQ = 4096, M = BATCH * SEQ, FF = 2816, NMODC = 9 * D;
constexpr int PWID = 512, SWID = 512, NG = 32, GH = 16, NS = 64;
constexpr int CL = 32, NCH = SEQ / CL, RPG = BATCH * NCH  , KA = 640  ;
constexpr float EPS = 1e-6f;
constexpr int MODKC = 16;

constexpr size_t MiB = 1u << 20;
constexpr size_t WS_PART = 0, WS_MOD = 5 * MiB, WS_A32 = 5 * MiB + 512 * 1024, WS_BAR = 5 * MiB + 768 * 1024, BAR_BYTES = 16384;
constexpr size_t WS_W1IN = 6 * MiB, WS_W1OUT = 17 * MiB, WS_WIN = 23 * MiB, WS_WPOOL = 29 * MiB, WS_WPUP = 30 * MiB, WS_WGLU = 31 * MiB,
                 WS_WSUP = 32 * MiB, WS_WOUT = 33 * MiB, WS_W2IN = 35 * MiB, WS_W2OUT = 46 * MiB, WS_BTE = 52 * MiB, WS_BTY = 60 * MiB;
constexpr size_t WS_H = 80 * MiB;
constexpr size_t WS_ACT = 144 * MiB;
constexpr size_t WS_UPOOL = 144 * MiB, WS_ASSM = 176 * MiB, WS_Z = 216 * MiB, WS_ZP = 248 * MiB, WS_E = 280 * MiB;
constexpr size_t WS_YG = WS_UPOOL, WS_SG = WS_Z;
constexpr size_t WS_SIGP = 320 * MiB, WS_SIGS = 384 * MiB, WS_RSS = 448 * MiB  , WS_SW = 450 * MiB  , WS_KT = 451 * MiB  , WS_END = 452 * MiB;

__device__ __forceinline__ unsigned cvt_pk_bf16(float lo, float hi) { unsigned r; asm volatile("v_cvt_pk_bf16_f32 %0, %1, %2" : "=v"(r) : "v"(lo), "v"(hi)); return r; }
__device__ __forceinline__ unsigned f2bf(float f) { unsigned u = __builtin_bit_cast(unsigned, f); return (u + 0x7fffu + ((u >> 16) & 1u)) >> 16; }
__device__ __forceinline__ float bflo(unsigned w) { return __builtin_bit_cast(float, w << 16); }
__device__ __forceinline__ float bfhi(unsigned w) { return __builtin_bit_cast(float, w & 0xffff0000u); }
__device__ __forceinline__ float sigm(float x) { return __builtin_amdgcn_rcpf(1.0f + __builtin_amdgcn_exp2f(x * -1.4426950408889634f)); }
typedef float f32x2 __attribute__((ext_vector_type(2)));
__device__ __forceinline__ f32x2 sigm2(f32x2 x) { const f32x2 t = x * -1.4426950408889634f; f32x2 e; e.x = __builtin_amdgcn_exp2f(t.x); e.y = __builtin_amdgcn_exp2f(t.y); const f32x2 d = e + 1.0f; f32x2 r; r.x = __builtin_amdgcn_rcpf(d.x); r.y = __builtin_amdgcn_rcpf(d.y); return r; }
__device__ __forceinline__ f32x4 sigm4(f32x4 x) { const f32x2 lo = sigm2((f32x2){x.x, x.y}), hi = sigm2((f32x2){x.z, x.w}); return (f32x4){lo.x, lo.y, hi.x, hi.y}; }
__device__ __forceinline__ f32x2 gelu_pk(f32x2 v) {
    const f32x2 av = __builtin_elementwise_abs(v), d = av * 0.2316418882f + 1.0f;
    f32x2 t; t.x = __builtin_amdgcn_rcpf(d.x); t.y = __builtin_amdgcn_rcpf(d.y);
    f32x2 q = t * 0.5307027145f + (-0.7265760135f); q = q * t + 0.7107068705f; q = q * t + (-0.142248368f); q = q * t + 0.127414796f; q = q * t;
    const f32x2 s = (v * v) * (-0.72134752044f);
    f32x2 e; e.x = __builtin_amdgcn_exp2f(s.x); e.y = __builtin_amdgcn_exp2f(s.y);
    const f32x2 m = v * (q * e), r = v - m;
    f32x2 o; o.x = v.x < 0.f ? m.x : r.x; o.y = v.y < 0.f ? m.y : r.y; return o;
}
__device__ __forceinline__ float wave_sum(float v) {
#pragma unroll
    for (int o = 1; o < 64; o <<= 1) v += __shfl_xor(v, o);
    return v;
}
#define LDS_WAIT() asm volatile("s_waitcnt lgkmcnt(0)" ::: "memory")

namespace pg8 {
constexpr int BM = 256, BK = 64, HALF = 128, HTB = HALF * BK * 2, STAGE_BYTES = 8 * HTB, NXCD = 8, WGM = 8;
__host__ __device__ __forceinline__ int lds_byte(int r, int c) { const int st = (r >> 4) * 2 + (c >> 5), rr = r & 15, cc = c & 31, ob = rr * 64 + cc * 2; return st * 1024 + (ob ^ (((ob >> 9) & 1) << 5)); }
__host__ __device__ __forceinline__ void stage_rc(int b, int& R, int& C) { const int st = b / 1024, sb = b % 1024, swz = sb ^ (((sb >> 9) & 1) << 5); R = (st >> 1) * 16 + swz / 64; C = (st & 1) * 32 + (swz % 64) / 2; }
__host__ __device__ __forceinline__ int perm32(int rho) { const int n = rho >> 4, i = rho & 15; return 8 * (i >> 2) + 4 * n + (i & 3); }

struct Unit { int pm, pn; };
struct Gemm { const bf16_t* A; const bf16_t* Bt; int lda, ldb, K; int kpn; };

struct StaticOrder {
    int nM, nN, nwg, G, c;
    __device__ void init(int Mr, int Nc, int G_, int c_) { nM = Mr / BM; nN = Nc / BM; nwg = nM * nN; G = G_; c = c_; }
    __device__ bool next(int i, Unit& u) const {
        const long L = (long)i * G + c; if (L >= nwg) return false;
        int wgid = (int)L; { const int q = nwg / NXCD, r = nwg % NXCD, xcd = wgid % NXCD, off = wgid / NXCD; wgid = (xcd < r ? xcd * (q + 1) : r * (q + 1) + (xcd - r) * q) + off; }
        const int nig = WGM * nN, gid = wgid / nig, fm = gid * WGM, gsz = (nM - fm) < WGM ? (nM - fm) : WGM;
        u.pm = fm + ((wgid % nig) % gsz); u.pn = (wgid % nig) / gsz; return true;
    }
};
struct OrderE {
    int G, c;
    __device__ bool next(int i, Unit& u) const { const int xcd = c & 7, slot = c >> 3; if (i > 0 || G != 256 || slot >= 16) return false; const int g = xcd * 4 + (slot >> 2); u.pm = g * 4 + (slot & 3); u.pn = g; return true; }
};
struct OrderY {
    int G, c;
    __device__ bool next(int i, Unit& u) const { const int xcd = c & 7, slot = c >> 3; if (i > 0 || G != 256) return false; const int g = xcd * 4 + (slot >> 3), rem = slot & 7; u.pm = g * 4 + (rem & 3); u.pn = g * 2 + (rem >> 2); return true; }
};

struct EpiEC;
struct OrderP1 {
    int G, c;
    __device__ bool next(int i, Unit& u) const { const int slot = c >> 3; if (i > 1 || G != 256 || slot < 16) return false; u.pm = (slot - 16) * 8 + (c & 7); u.pn = i; return true; }
};
template <class T> struct epi_after_drain { static constexpr bool value = false; };
template <> struct epi_after_drain<EpiEC> { static constexpr bool value = true; };
template <class Epi, class Sched, bool ALIGN_EPI>
__device__ __forceinline__ void gemm_phase(LAS unsigned char* lds, const Gemm g, const Sched& S, const Epi& E) {
    int tid_ = threadIdx.x; asm volatile("" : "+v"(tid_));
    const int tid = tid_, wid = __builtin_amdgcn_readfirstlane(tid >> 6), lane = tid & 63, wr = wid >> 2, wc = wid & 3, fr = lane & 15, fq = lane >> 4;
    const int K = g.K, nt = K / BK;
    unsigned voffA[2], voffB[2];
#pragma unroll
    for (int i = 0; i < 2; ++i) { int R, C; stage_rc(tid * 16 + i * 8192, R, C); const int Rb = Epi::PERM ? ((R & ~31) + perm32(R & 31)) : R;
        voffA[i] = (unsigned)(R * g.lda + C) * 2u; voffB[i] = (unsigned)(Rb * g.ldb + C) * 2u; }
    const size_t kstep = (size_t)(BK * 2);
    const size_t hstepA = (size_t)HALF * g.lda * 2, hstepB = (size_t)HALF * g.ldb * 2;
    const size_t tstepA = 2 * hstepA, tstepB = 2 * hstepB;
    const unsigned ldsw = (unsigned)wid * 1024u;
    const int aoff = lds_byte(wr * 64 + fr, fq * 8), boff = lds_byte(wc * 32 + fr, fq * 8);
#define PG8_SA(b, h) (((b) * 2 + (h)) * HTB)
#define PG8_SB(b, h) ((4 + (b) * 2 + (h)) * HTB)
#define PG8_STAGE(bufoff, gbase, voff) do { _Pragma("unroll") for (int _i = 0; _i < 2; ++_i) \
        __builtin_amdgcn_global_load_lds((const unsigned*)((const char*)(gbase) + (voff)[_i]), (LAS unsigned*)(lds + (bufoff) + ldsw + _i * 8192), 16, 0, 0); } while (0)
#define PG8_LDA(dst, b, h) do { _Pragma("unroll") for (int m = 0; m < 4; ++m) _Pragma("unroll") for (int k = 0; k < 2; ++k) dst[m][k] = *(const LAS bf16x8*)(lds + PG8_SA(b, h) + aoff + m * 2048 + k * 1024); } while (0)
#define PG8_LDB(dst, b, h) do { _Pragma("unroll") for (int n = 0; n < 2; ++n) _Pragma("unroll") for (int k = 0; k < 2; ++k) dst[n][k] = *(const LAS bf16x8*)(lds + PG8_SB(b, h) + boff + n * 2048 + k * 1024); } while (0)
#define PG8_MMA(ai, bj, At, Bt) do { __builtin_amdgcn_s_setprio(1); _Pragma("unroll") for (int m = 0; m < 4; ++m) _Pragma("unroll") for (int n = 0; n < 2; ++n) _Pragma("unroll") for (int k = 0; k < 2; ++k) \
        acc[ai][bj][m][n] = __builtin_amdgcn_mfma_f32_16x16x32_bf16(Bt[n][k], At[m][k], acc[ai][bj][m][n], 0, 0, 0); __builtin_amdgcn_s_setprio(0); } while (0)
#define PG8_WAIT_V(n) asm volatile("s_waitcnt vmcnt(" #n ")" ::: "memory")
#define PG8_WAIT_L(n) asm volatile("s_waitcnt lgkmcnt(" #n ")" ::: "memory")
#define PG8_BAR __builtin_amdgcn_s_barrier()
#define PG8_SCHED __builtin_amdgcn_sched_barrier(0)
    Unit cur, nxt; int ui = 0;
    if (!S.next(0, cur)) return;
    f32x4 acc[2][2][4][2];
#pragma unroll
    for (int a = 0; a < 2; ++a)
#pragma unroll
        for (int b = 0; b < 2; ++b)
#pragma unroll
            for (int m = 0; m < 4; ++m)
#pragma unroll
                for (int n = 0; n < 2; ++n) acc[a][b][m][n] = (f32x4){0.f, 0.f, 0.f, 0.f};
    bf16x8 At[4][2], B0[2][2], B1[2][2];
    const char* cA = (const char*)g.A + (size_t)cur.pm * tstepA + (size_t)cur.pn * g.kpn; const char* cB = (const char*)g.Bt + (size_t)cur.pn * tstepB + (size_t)cur.pn * g.kpn;
    PG8_STAGE(PG8_SB(0, 0), cB, voffB); PG8_STAGE(PG8_SB(0, 1), cB + hstepB, voffB); PG8_STAGE(PG8_SA(0, 0), cA, voffA); PG8_STAGE(PG8_SA(0, 1), cA + hstepA, voffA);
    if (wr == 1) PG8_BAR;
    PG8_WAIT_V(2); PG8_BAR;
    PG8_STAGE(PG8_SB(1, 0), cB + kstep, voffB); PG8_STAGE(PG8_SA(1, 0), cA + kstep, voffA); PG8_STAGE(PG8_SB(1, 1), cB + hstepB + kstep, voffB);
    PG8_WAIT_V(6); PG8_BAR;
    for (;;) {
        const bool has_next = S.next(ui + 1, nxt);
        const char* nA = has_next ? (const char*)g.A + (size_t)nxt.pm * tstepA + (size_t)nxt.pn * g.kpn : cA; const char* nB = has_next ? (const char*)g.Bt + (size_t)nxt.pn * tstepB + (size_t)nxt.pn * g.kpn : cB;
#pragma nounroll
        for (int t = 0; t < nt; t += 2) {
            const bool last = (t == nt - 2);
            const char* a1 = cA + (size_t)(t + 1) * kstep;
            const char* a2 = last ? nA : cA + (size_t)(t + 2) * kstep; const char* b2 = last ? nB : cB + (size_t)(t + 2) * kstep;
            const char* a3 = a2 + kstep; const char* b3 = b2 + kstep;
            PG8_LDB(B0, 0, 0); PG8_LDB(B1, 0, 1); PG8_SCHED; PG8_LDA(At, 0, 0); PG8_STAGE(PG8_SA(1, 1), a1 + hstepA, voffA);
            PG8_WAIT_V(8); PG8_WAIT_L(0); PG8_BAR; PG8_MMA(0, 0, At, B0); PG8_MMA(0, 1, At, B1); PG8_BAR; PG8_SCHED;
            PG8_LDA(At, 0, 1); PG8_STAGE(PG8_SB(0, 0), b2, voffB); PG8_STAGE(PG8_SB(0, 1), b2 + hstepB, voffB); PG8_STAGE(PG8_SA(0, 0), a2, voffA);
            PG8_WAIT_V(8); PG8_WAIT_L(0); PG8_BAR; PG8_MMA(1, 0, At, B0); PG8_MMA(1, 1, At, B1); PG8_BAR; PG8_SCHED;
            PG8_LDB(B0, 1, 0); PG8_LDB(B1, 1, 1); PG8_SCHED; PG8_LDA(At, 1, 0); PG8_STAGE(PG8_SA(0, 1), a2 + hstepA, voffA);
            PG8_WAIT_V(8); PG8_WAIT_L(0); PG8_BAR; PG8_MMA(0, 0, At, B0); PG8_MMA(0, 1, At, B1); PG8_BAR; PG8_SCHED;
            PG8_LDA(At, 1, 1); PG8_STAGE(PG8_SB(1, 0), b3, voffB); PG8_STAGE(PG8_SB(1, 1), b3 + hstepB, voffB); PG8_STAGE(PG8_SA(1, 0), a3, voffA);
            PG8_WAIT_V(8); PG8_WAIT_L(0); PG8_BAR; PG8_MMA(1, 0, At, B0); PG8_MMA(1, 1, At, B1); PG8_BAR; PG8_SCHED;
        }
        if constexpr (ALIGN_EPI) { if (wr == 0) PG8_BAR; }
        if constexpr (!epi_after_drain<Epi>::value) E(acc, cur, ui, wr, wc, fr, fq);
        if (!has_next) break;
#pragma unroll
        for (int a = 0; a < 2; ++a)
#pragma unroll
            for (int b = 0; b < 2; ++b)
#pragma unroll
                for (int m = 0; m < 4; ++m)
#pragma unroll
                    for (int n = 0; n < 2; ++n) acc[a][b][m][n] = (f32x4){0.f, 0.f, 0.f, 0.f};
        cur = nxt; cA = nA; cB = nB; ++ui;
        if constexpr (ALIGN_EPI) { if (wr == 1) PG8_BAR; }
    }
    PG8_WAIT_V(0);
    if constexpr (!ALIGN_EPI) { if (wr == 0) PG8_BAR; }
    PG8_BAR;
    if constexpr (epi_after_drain<Epi>::value) E.fused(acc, cur, wr, wc, fr, fq, lds, wid, lane);
#undef PG8_SA
#undef PG8_SB
#undef PG8_STAGE
#undef PG8_LDA
#undef PG8_LDB
#undef PG8_MMA
#undef PG8_WAIT_V
#undef PG8_WAIT_L
#undef PG8_BAR
#undef PG8_SCHED
}

typedef f32x4 Acc[2][2][4][2];

__device__ __forceinline__ u32x4 pack8(const f32x4 v0, const f32x4 v1) { u32x4 w; w.x = cvt_pk_bf16(v0[0], v0[1]); w.y = cvt_pk_bf16(v0[2], v0[3]); w.z = cvt_pk_bf16(v1[0], v1[1]); w.w = cvt_pk_bf16(v1[2], v1[3]); return w; }
__device__ __forceinline__ void unpack8(const u32x4 w, f32x4& v0, f32x4& v1) { v0 = (f32x4){bflo(w.x), bfhi(w.x), bflo(w.y), bfhi(w.y)}; v1 = (f32x4){bflo(w.z), bfhi(w.z), bflo(w.w), bfhi(w.w)}; }

template <bool NORM> struct EpiSwiGLU {
    static constexpr bool PERM = true;
    bf16_t* O; int ldo; const LAS float* rstdL; const LAS float* swL;
    __device__ __forceinline__ void operator()(const Acc& acc, const Unit& u, int ui, int wr, int wc, int fr, int fq) const {
        const int col0 = u.pn * HALF + wc * 32 + 8 * fq;
        f32x4 sa[2], sb[2];
        if (NORM) { const LAS float* sp = swL + ui * 256 + wc * 32 + 8 * fq;
#pragma unroll
            for (int n = 0; n < 2; ++n) { sa[n] = *(const LAS f32x4*)(sp + 4 * n); sb[n] = *(const LAS f32x4*)(sp + HALF + 4 * n); } }
#pragma unroll
        for (int ai = 0; ai < 2; ++ai)
#pragma unroll
            for (int m = 0; m < 4; ++m) {
                const int rl = wr * 64 + fr + ai * HALF + m * 16, r = u.pm * BM + rl;
                float rstd = 1.0f;
                if (NORM) rstd = rstdL[ui * 256 + rl];
                f32x4 v[2];
#pragma unroll
                for (int n = 0; n < 2; ++n) { f32x4 a = acc[ai][0][m][n], b = acc[ai][1][m][n];
                    if (NORM) { a = a * rstd + sa[n]; b = b * rstd + sb[n]; }
                    v[n] = (a * b) * sigm4(a); }
                *(u32x4*)(O + (size_t)r * ldo + col0) = pack8(v[0], v[1]);
            }
    }
};
struct EpiGLU {
    static constexpr bool PERM = true;
    bf16_t* O; int ldo; const float* bias; int nhalf;
    __device__ __forceinline__ void operator()(const Acc& acc, const Unit& u, int ui, int wr, int wc, int fr, int fq) const {
        const int row0 = u.pm * BM + wr * 64 + fr, col0 = u.pn * HALF + wc * 32 + 8 * fq;
        f32x4 bv[2], bg[2];
#pragma unroll
        for (int n = 0; n < 2; ++n) { bv[n] = *(const f32x4*)(bias + col0 + 4 * n); bg[n] = *(const f32x4*)(bias + nhalf + col0 + 4 * n); }
#pragma unroll
        for (int ai = 0; ai < 2; ++ai)
#pragma unroll
            for (int m = 0; m < 4; ++m) {
                f32x4 v[2];
#pragma unroll
                for (int n = 0; n < 2; ++n) { const f32x4 a = acc[ai][0][m][n] + bv[n], b = acc[ai][1][m][n] + bg[n];
                    v[n] = a * sigm4(b); }
                *(u32x4*)(O + (size_t)(row0 + ai * HALF + m * 16) * ldo + col0) = pack8(v[0], v[1]);
            }
    }
};
template <bool NEXT, bool HALFS> struct EpiResid {
    static constexpr bool PERM = false;
    static constexpr float s = HALFS ? 0.5f : 1.0f;
    const float* base; float* out; const float* gate0;
    bf16_t* xg; const float* gnext; const float* scale0; float* rss;
    __device__ __forceinline__ void operator()(const Acc& acc, const Unit& u, int ui, int wr, int wc, int fr, int fq) const {
        const int row0 = u.pm * BM + wr * 64 + fr, col0 = u.pn * BM + wc * 32 + 4 * fq;
        const float* gate = gate0 + (size_t)(u.pm >> 4) * NMODC;
        const char* bp = (const char*)base; char* op = (char*)out; char* xp = (char*)xg;
        unsigned rb[2][4];
        float ss[2][4];
#pragma unroll
        for (int ai = 0; ai < 2; ++ai)
#pragma unroll
            for (int m = 0; m < 4; ++m) { ss[ai][m] = 0.f; rb[ai][m] = (unsigned)((row0 + ai * HALF + m * 16) * D + col0) * 4u; }
#pragma unroll
        for (int bj = 0; bj < 2; ++bj)
#pragma unroll
            for (int n = 0; n < 2; ++n) {
                const int c = col0 + bj * HALF + n * 16; const unsigned cb = (unsigned)(bj * HALF + n * 16) * 4u;
                f32x4 bs[2][4];
#pragma unroll
                for (int ai = 0; ai < 2; ++ai)
#pragma unroll
                    for (int m = 0; m < 4; ++m) bs[ai][m] = *(const f32x4*)(bp + (rb[ai][m] + cb));
                const f32x4 gv = *(const f32x4*)(gate + c) * s;
                f32x4 gsv = gv;
                if (NEXT) gsv = *(const f32x4*)(gnext + c) * (*(const f32x4*)(scale0 + (size_t)(u.pm >> 4) * NMODC + c) + 1.0f);
#pragma unroll
                for (int ai = 0; ai < 2; ++ai)
#pragma unroll
                    for (int m = 0; m < 4; ++m) {
                        const f32x4 xn = bs[ai][m] + gv * acc[ai][bj][m][n];
                        *(f32x4*)(op + (rb[ai][m] + cb)) = xn;
                        if (NEXT) { ss[ai][m] += (xn.x * xn.x + xn.y * xn.y) + (xn.z * xn.z + xn.w * xn.w); const f32x4 o = xn * gsv; u32x2 w; w.x = cvt_pk_bf16(o.x, o.y); w.y = cvt_pk_bf16(o.z, o.w);
                            *(u32x2*)(xp + ((rb[ai][m] + cb) >> 1)) = w; } }
            }
        if (NEXT) {
#pragma unroll
            for (int ai = 0; ai < 2; ++ai)
#pragma unroll
                for (int m = 0; m < 4; ++m) { float t = ss[ai][m]; t += __shfl_xor(t, 16); t += __shfl_xor(t, 32); if (fq == 0) rss[(size_t)(row0 + ai * HALF + m * 16) * 16 + u.pn * 4 + wc] = t; }
        }
    }
};
struct EpiWin {
    static constexpr bool PERM = true;
    bf16_t *upool, *assm, *sigp, *sigs; const LAS float* rstdL; const LAS float* swL;
    __device__ __forceinline__ void operator()(const Acc& acc, const Unit& u, int ui, int wr, int wc, int fr, int fq) const {
        const int pn = u.pn;
        f32x4 sv[2][2];
        { const LAS float* sp = swL + ui * 256 + wc * 32 + 8 * fq;
#pragma unroll
          for (int bj = 0; bj < 2; ++bj)
#pragma unroll
              for (int n = 0; n < 2; ++n) sv[bj][n] = *(const LAS f32x4*)(sp + bj * HALF + 4 * n); }
#pragma unroll
        for (int ai = 0; ai < 2; ++ai)
#pragma unroll
            for (int m = 0; m < 4; ++m) { const int rl = wr * 64 + fr + ai * HALF + m * 16, r = u.pm * BM + rl;
                const float rstd = rstdL[ui * 256 + rl];
#pragma unroll
                for (int bj = 0; bj < 2; ++bj) {
                    f32x4 v0 = acc[ai][bj][m][0] * rstd + sv[bj][0], v1 = acc[ai][bj][m][1] * rstd + sv[bj][1];
                    const int cl = bj * HALF + wc * 32 + 8 * fq;
                    if (pn < 2) { *(u32x4*)(upool + (size_t)r * PWID + pn * BM + cl) = pack8(v0, v1); }
                    else if (pn < 4) { const int cs = (pn - 2) * BM + cl, g = cs >> 4, h0 = cs & 15;
                        *(u32x4*)(assm + ((size_t)(g * RPG + (r >> 5)) * KA + (r & 31) * GH + h0)) = pack8(v0, v1); }
                    else {
                        v0 = sigm4(v0); v1 = sigm4(v1);
                        bf16_t* dst = (pn < 8) ? (sigp + (size_t)r * D + (pn - 4) * BM + cl) : (sigs + (size_t)r * D + (pn - 8) * BM + cl);
                        *(u32x4*)dst = pack8(v0, v1); }
                } }
    }
};
struct EpiPool1 {
    static constexpr bool PERM = true;
    bf16_t* O; const float* pb; const float* ps;
    __device__ __forceinline__ void operator()(const Acc& acc, const Unit& u, int ui, int wr, int wc, int fr, int fq) const {
        const int row0 = u.pm * BM + wr * 64 + fr, col0 = u.pn * BM + wc * 32 + 8 * fq;
        f32x4 b[2][2], s[2][2];
#pragma unroll
        for (int bj = 0; bj < 2; ++bj)
#pragma unroll
            for (int n = 0; n < 2; ++n) { b[bj][n] = *(const f32x4*)(pb + col0 + bj * HALF + 4 * n); s[bj][n] = *(const f32x4*)(ps + col0 + bj * HALF + 4 * n); }
#pragma unroll
        for (int ai = 0; ai < 2; ++ai)
#pragma unroll
            for (int m = 0; m < 4; ++m) { bf16_t* rowp = O + (size_t)(row0 + ai * HALF + m * 16) * PWID + col0;
#pragma unroll
                for (int bj = 0; bj < 2; ++bj) *(u32x4*)(rowp + bj * HALF) = pack8((acc[ai][bj][m][0] + b[bj][0]) * s[bj][0], (acc[ai][bj][m][1] + b[bj][1]) * s[bj][1]); }
    }
};
template <bool ADD> struct EpiGateAcc {
    static constexpr bool PERM = true;
    bf16_t* O; const bf16_t* sig;
    __device__ __forceinline__ void operator()(const Acc& acc, const Unit& u, int ui, int wr, int wc, int fr, int fq) const {
        const int row0 = u.pm * BM + wr * 64 + fr, col0 = u.pn * BM + wc * 32 + 8 * fq;
#pragma unroll
        for (int ai = 0; ai < 2; ++ai) {
            u32x4 sg[4][2], pv[4][2];
#pragma unroll
            for (int m = 0; m < 4; ++m)
#pragma unroll
                for (int bj = 0; bj < 2; ++bj) { const size_t off = (size_t)(row0 + ai * HALF + m * 16) * D + col0 + bj * HALF; sg[m][bj] = *(const u32x4*)(sig + off); if (ADD) pv[m][bj] = *(const u32x4*)(O + off); }
#pragma unroll
            for (int m = 0; m < 4; ++m) { const size_t off = (size_t)(row0 + ai * HALF + m * 16) * D + col0;
#pragma unroll
                for (int bj = 0; bj < 2; ++bj) { f32x4 s0, s1; unpack8(sg[m][bj], s0, s1);
                    f32x4 v0 = s0 * acc[ai][bj][m][0], v1 = s1 * acc[ai][bj][m][1];
                    if (ADD) { f32x4 p0, p1; unpack8(pv[m][bj], p0, p1); v0 += p0; v1 += p1; }
                    *(u32x4*)(O + off + bj * HALF) = pack8(v0, v1); } }
        }
    }
};
struct EpiPlain {
    static constexpr bool PERM = true;
    bf16_t* O; int ldo;
    __device__ __forceinline__ void operator()(const Acc& acc, const Unit& u, int ui, int wr, int wc, int fr, int fq) const {
        const int row0 = u.pm * BM + wr * 64 + fr, col0 = u.pn * BM + wc * 32 + 8 * fq;
#pragma unroll
        for (int ai = 0; ai < 2; ++ai)
#pragma unroll
            for (int m = 0; m < 4; ++m) { bf16_t* rowp = O + (size_t)(row0 + ai * HALF + m * 16) * ldo + col0;
#pragma unroll
                for (int bj = 0; bj < 2; ++bj) *(u32x4*)(rowp + bj * HALF) = pack8(acc[ai][bj][m][0], acc[ai][bj][m][1]); }
    }
};
struct EpiEC {
    static constexpr bool PERM = false;
    bf16_t* assm; const float* a32;
    __device__ __forceinline__ void operator()(const Acc&, const Unit&, int, int, int, int, int) const {}
    __device__ __forceinline__ void fused(const Acc& acc, const Unit& u, int wr, int wc, int fr, int fq, LAS unsigned char* lds, int wid, int lane) const {
        LAS float* EL = (LAS float*)lds;
#pragma unroll
        for (int ai = 0; ai < 2; ++ai)
#pragma unroll
            for (int m = 0; m < 4; ++m) { const int rl = ai * HALF + wr * 64 + m * 16 + fr;
#pragma unroll
                for (int n = 0; n < 2; ++n) *(LAS f32x4*)(EL + rl * 128 + wc * 32 + n * 16 + 4 * fq) = acc[ai][0][m][n]; }
        __syncthreads();
        if (wid < 2) { const int g = u.pm >> 2, n = lane; const size_t arow0 = (size_t)u.pm * BM + wid * 128;
            const float ar = a32[(g * NS + n) * 2], ai_ = a32[(g * NS + n) * 2 + 1];
            float sr = 0.f, si = 0.f;
#pragma unroll 8
            for (int c = 0; c < NCH; ++c) { const float er = EL[(wid * 128 + c) * 128 + n], ei = EL[(wid * 128 + c) * 128 + 64 + n];
                assm[(arow0 + c) * KA + 512 + n] = (bf16_t)f2bf(sr); assm[(arow0 + c) * KA + 576 + n] = (bf16_t)f2bf(si);
                const float q = ar * sr - ai_ * si + er; si = ar * si + ai_ * sr + ei; sr = q; } }
        __syncthreads();
    }
};
struct EpiE {
    static constexpr bool PERM = false;
    float* E;
    __device__ __forceinline__ void operator()(const Acc& acc, const Unit& u, int ui, int wr, int wc, int fr, int fq) const {
        const int row0 = u.pm * BM + wr * 64 + fr, col0 = wc * 32 + 4 * fq;
#pragma unroll
        for (int ai = 0; ai < 2; ++ai)
#pragma unroll
            for (int m = 0; m < 4; ++m) { float* rowp = E + (size_t)(row0 + ai * HALF + m * 16) * 128 + col0;
#pragma unroll
                for (int n = 0; n < 2; ++n) *(f32x4*)(rowp + n * 16) = acc[ai][0][m][n]; }
    }
};
struct EpiY {
    static constexpr bool PERM = true;
    bf16_t* yg; const bf16_t* assm; const float* dskip;
    __device__ __forceinline__ void operator()(const Acc& acc, const Unit& u, int ui, int wr, int wc, int fr, int fq) const {
        const int g = u.pm >> 2, pnl = u.pn & 1;
        const int arow0 = u.pm * BM + wr * 64 + fr;
#pragma unroll
        for (int bj = 0; bj < 2; ++bj) {
            const int nloc = pnl * BM + bj * HALF + wc * 32 + 8 * fq, tl = nloc >> 4, h0 = nloc & 15;
            const f32x4 d0 = *(const f32x4*)(dskip + g * GH + h0), d1 = *(const f32x4*)(dskip + g * GH + h0 + 4);
            u32x4 uu[2][4];
#pragma unroll
            for (int ai = 0; ai < 2; ++ai)
#pragma unroll
                for (int m = 0; m < 4; ++m) uu[ai][m] = *(const u32x4*)(assm + (size_t)(arow0 + ai * HALF + m * 16) * KA + nloc);
#pragma unroll
            for (int ai = 0; ai < 2; ++ai)
#pragma unroll
                for (int m = 0; m < 4; ++m) { const int arow = arow0 + ai * HALF + m * 16, rl = arow - g * RPG;
                    f32x4 u0, u1; unpack8(uu[ai][m], u0, u1);
                    f32x4 v0 = acc[ai][bj][m][0] + d0 * u0, v1 = acc[ai][bj][m][1] + d1 * u1;
                    { const f32x2 g0 = gelu_pk((f32x2){v0[0], v0[1]}), g1 = gelu_pk((f32x2){v0[2], v0[3]}), g2 = gelu_pk((f32x2){v1[0], v1[1]}), g3 = gelu_pk((f32x2){v1[2], v1[3]});
                      v0 = (f32x4){g0.x, g0.y, g1.x, g1.y}; v1 = (f32x4){g2.x, g2.y, g3.x, g3.y}; }
                    *(u32x4*)(yg + (size_t)(rl * CL + tl) * SWID + g * GH + h0) = pack8(v0, v1); }
        }
    }
};
}

#define XB_TMO      128
#define XB_XCNT(j)  (256  + 64 * (j))
#define XB_XSUB(j)  (1280 + 64 * (j))
#define XB_XGEN(j)  (2304 + 64 * (j))
#define XB_TOP      3328
#define XB_TOPGEN   3392
#define XCD_BAR_WORDS 3456
#define XB_SPIN_CAP (1u << 22)
__device__ __forceinline__ unsigned xb_ld(unsigned* p)              { return __hip_atomic_load(p, __ATOMIC_RELAXED, __HIP_MEMORY_SCOPE_AGENT); }
__device__ __forceinline__ unsigned xb_add(unsigned* p, unsigned v) { return __hip_atomic_fetch_add(p, v, __ATOMIC_RELAXED, __HIP_MEMORY_SCOPE_AGENT); }
__device__ __forceinline__ unsigned xb_xcc_id() { return (unsigned)__builtin_amdgcn_s_getreg((3 << 11) | 20) & 0xFu; }
#define XB_SPIN(cond, bar) do { unsigned _sp = 0; while (cond) { __builtin_amdgcn_s_sleep(1); \
    if ((++_sp & 255u) == 0u) { if (xb_ld(&(bar)[XB_TMO])) break; if (_sp > XB_SPIN_CAP) { atomicAdd(&(bar)[XB_TMO], 1u); break; } } } } while (0)
struct XcdBarrier { unsigned* bar; unsigned x; volatile LAS unsigned* st; };
__device__ __forceinline__ XcdBarrier xcd_barrier_post(unsigned* bar, volatile LAS unsigned* st) {
    XcdBarrier b; b.bar = bar; b.x = xb_xcc_id(); b.st = st;
    if (threadIdx.x == 0) (void)xb_add(&bar[XB_XCNT(b.x)], 1u);
    return b;
}
__device__ __forceinline__ void xcd_barrier_complete(unsigned* bar, unsigned x, unsigned& nloc, unsigned& nx) {
    const unsigned G = gridDim.x * gridDim.y * gridDim.z;
    unsigned sum, cnt, mine, sp = 0u;
    for (;;) {
        sum = 0u; cnt = 0u; mine = 0u;
#pragma unroll
        for (unsigned j = 0; j < 16; ++j) { const unsigned c = xb_ld(&bar[XB_XCNT(j)]); sum += c; cnt += (c > 0u) ? 1u : 0u; mine = (j == x) ? c : mine; }
        if (sum == G) break;
        __builtin_amdgcn_s_sleep(1);
        if ((++sp & 255u) == 0u) { if (xb_ld(&bar[XB_TMO])) break; if (sp > XB_SPIN_CAP) { atomicAdd(&bar[XB_TMO], 1u); break; } }
    }
    nloc = mine > 0u ? mine : 1u; nx = cnt > 0u ? cnt : 1u;
}
__device__ __forceinline__ void xcd_barrier(const XcdBarrier& b) {
    asm volatile("s_waitcnt vmcnt(0)" ::: "memory");
    __syncthreads();
    if (threadIdx.x == 0) {
        unsigned* bar = b.bar;
        __builtin_amdgcn_s_waitcnt(0);
        unsigned nloc = b.st[0], nx = b.st[1];
        if (nloc == 0u) { xcd_barrier_complete(bar, b.x, nloc, nx); b.st[0] = nloc; b.st[1] = nx; }
        const unsigned old = xb_add(&bar[XB_XSUB(b.x)], 1u);
        const unsigned gen = old / nloc;
        if (old + 1u == (gen + 1u) * nloc) {
            __builtin_amdgcn_fence(__ATOMIC_RELEASE, "agent");
            asm volatile("s_waitcnt vmcnt(0)" ::: "memory");
            const unsigned og = xb_add(&bar[XB_TOP], 1u);
            const unsigned tg = og / nx;
            if (og + 1u == (tg + 1u) * nx) xb_add(&bar[XB_TOPGEN], 1u);
            else XB_SPIN(xb_ld(&bar[XB_TOPGEN]) == tg, bar);
            __builtin_amdgcn_fence(__ATOMIC_ACQUIRE, "agent");
            xb_add(&bar[XB_XGEN(b.x)], 1u);
            asm volatile("s_waitcnt vmcnt(0)" ::: "memory");
        } else {
            XB_SPIN(xb_ld(&bar[XB_XGEN(b.x)]) == gen, bar);
            __builtin_amdgcn_fence(__ATOMIC_ACQUIRE, "agent");
            asm volatile("s_waitcnt vmcnt(0)" ::: "memory");
        }
    }
    __syncthreads();
}

struct Args { const float* in[29]; float* out; unsigned char* ws; };

__device__ __forceinline__ void transpose_block(const float* __restrict__ W, int N, bf16_t* WT, int ldo, int k0, int n0, int orow0, LAS float* scr, int lane) {
    float t[32];
    const float* Wk = W + (size_t)k0 * N + n0;
    const unsigned lo = (unsigned)((lane >> 5) * N + (lane & 31));
#pragma unroll
    for (int i = 0; i < 32; ++i) t[i] = __builtin_nontemporal_load((Wk + (size_t)(2 * i) * N) + lo);
#pragma unroll
    for (int i = 0; i < 32; ++i) { const int kk = 2 * i + (lane >> 5); scr[kk * 33 + (lane & 31)] = t[i]; }
    LDS_WAIT();
    const int c = lane & 7;
#pragma unroll
    for (int j = 0; j < 4; ++j) { const int n = (lane >> 3) + 8 * j; const LAS float* s = scr + (8 * c) * 33 + n;
        u32x4 o; o.x = cvt_pk_bf16(s[0 * 33], s[1 * 33]); o.y = cvt_pk_bf16(s[2 * 33], s[3 * 33]); o.z = cvt_pk_bf16(s[4 * 33], s[5 * 33]); o.w = cvt_pk_bf16(s[6 * 33], s[7 * 33]);
        *(u32x4*)(WT + (size_t)(orow0 + n) * ldo + k0 + 8 * c) = o; }
    LDS_WAIT();
}
__device__ __forceinline__ void transpose_item(const float* W, int K, int N, bf16_t* WT, int nhalf, int item, LAS float* scr, int lane) {
    const int nblk = N / 32, kb = item / nblk, nb = item % nblk, k0 = 64 * kb, n0 = 32 * nb;
    int orow0 = n0;
    if (nhalf > 0) { const int h = n0 / nhalf, j = n0 % nhalf; orow0 = 256 * (j / 128) + 128 * h + (j % 128); }
    transpose_block(W, N, WT, K, k0, n0, orow0, scr, lane);
}

__device__ __forceinline__ void ssm_prep_stage1(const Args& a, int g, int sub, LAS float* L, int tid) {
    LAS float* PWR = L; LAS float* PWI = L + 2112; LAS float* BBR = L + 4224; LAS float* BBI = L + 5248; LAS float* CR = L + 6272; LAS float* CI = L + 7296;
    const float* lam_re_log = a.in[13]; const float* lam_im = a.in[14]; const float* log_dt = a.in[15];
    const float* b_re = a.in[16]; const float* b_im = a.in[17]; const float* c_re = a.in[18]; const float* c_im = a.in[19];
    bf16_t* BtY = (bf16_t*)(a.ws + WS_BTY); bf16_t* BtE = (bf16_t*)(a.ws + WS_BTE); float* A32 = (float*)(a.ws + WS_A32); float* KTg = (float*)(a.ws + WS_KT);
    if (tid < 64) {
        const int n = tid;
        const float lr = -expf(lam_re_log[g * NS + n]), li = lam_im[g * NS + n], dt = expf(log_dt[g]);
        const float mag = expf(lr * dt), ang = li * dt;
        const float abr = mag * cosf(ang), abi = mag * sinf(ang);
        const float nr = abr - 1.0f, ni = abi, den = lr * lr + li * li;
        const float fr = (nr * lr + ni * li) / den, fi = (ni * lr - nr * li) / den;
        float pr = 1.0f, pi = 0.0f;
        for (int tau = 0; tau <= CL; ++tau) { PWR[tau * NS + n] = pr; PWI[tau * NS + n] = pi; const float q = pr * abr - pi * abi; pi = pr * abi + pi * abr; pr = q; }
        if (sub == 0) { A32[(g * NS + n) * 2] = PWR[CL * NS + n]; A32[(g * NS + n) * 2 + 1] = PWI[CL * NS + n]; }
        for (int hp = 0; hp < GH; ++hp) { const float br = b_re[(g * NS + n) * GH + hp], bi = b_im[(g * NS + n) * GH + hp];
            BBR[n * GH + hp] = fr * br - fi * bi; BBI[n * GH + hp] = fr * bi + fi * br; }
    }
    for (int e = tid; e < GH * NS; e += 512) { CR[e] = c_re[g * GH * NS + e]; CI[e] = c_im[g * GH * NS + e]; }
    __syncthreads();
    for (int e = tid; e < 4 * GH * GH; e += 512) { const int tau = 4 * sub + (e >> 8), h = (e >> 4) & 15, hp = e & 15; float s = 0.f;
        for (int n = 0; n < NS; ++n) { const float pr = PWR[tau * NS + n], pi = PWI[tau * NS + n], br = BBR[n * GH + hp], bi = BBI[n * GH + hp];
            const float Pr = pr * br - pi * bi, Pi = pr * bi + pi * br; s += CR[h * NS + n] * Pr - CI[h * NS + n] * Pi; }
        KTg[(size_t)g * (CL * 256) + tau * 256 + (e & 255)] = s; }
    for (int q = tid; q < 64 * 16; q += 512) { const int row = 64 * sub + (q >> 4), ch = q & 15, t = row >> 4, h = row & 15, isim = ch >> 3, n0 = (ch & 7) * 8;
        float v[8];
#pragma unroll
        for (int j = 0; j < 8; ++j) { const int n = n0 + j; const float cr = CR[h * NS + n], ci = CI[h * NS + n], pr = PWR[(t + 1) * NS + n], pi = PWI[(t + 1) * NS + n];
            v[j] = isim ? -(cr * pi + ci * pr) : (cr * pr - ci * pi); }
        u32x4 o; o.x = cvt_pk_bf16(v[0], v[1]); o.y = cvt_pk_bf16(v[2], v[3]); o.z = cvt_pk_bf16(v[4], v[5]); o.w = cvt_pk_bf16(v[6], v[7]);
        *(u32x4*)(BtY + ((size_t)(g * 512 + row) * KA + 512 + isim * 64 + n0)) = o; }
    for (int q = tid; q < 32 * 64; q += 512) { const int row = 32 * sub + (q >> 6), ch = q & 63, s = ch >> 1, hp0 = (ch & 1) * 8;
        u32x4 o = (u32x4){0u, 0u, 0u, 0u};
        if (row < 128) { const int n = row & 63, isim = row >> 6; const float pr = PWR[(CL - 1 - s) * NS + n], pi = PWI[(CL - 1 - s) * NS + n];
            float v[8];
#pragma unroll
            for (int j = 0; j < 8; ++j) { const float br = BBR[n * GH + hp0 + j], bi = BBI[n * GH + hp0 + j]; v[j] = isim ? (pr * bi + pi * br) : (pr * br - pi * bi); }
            o.x = cvt_pk_bf16(v[0], v[1]); o.y = cvt_pk_bf16(v[2], v[3]); o.z = cvt_pk_bf16(v[4], v[5]); o.w = cvt_pk_bf16(v[6], v[7]); }
        *(u32x4*)(BtE + ((size_t)(g * 256 + row) * 512 + s * GH + hp0)) = o; }
    __syncthreads();
}

template <bool HASD, bool WRX, bool FINAL, bool XOUTB = false>
__device__ __forceinline__ void row_pass(const float* Xin, const bf16_t* delta, const float* gate0, float s, float* Xout, const float* gvec, const float* mod, int sub, bf16_t* Hout, int gw, int ngw, int lane) {
    for (int blk = gw; blk < M / 16; blk += ngw) {
        const int r0 = blk * 16, b = r0 / SEQ;
        f32x4 gs[4], sh[4], gt[4];
#pragma unroll
        for (int j = 0; j < 4; ++j) { const int c = 4 * lane + 256 * j; const f32x4 gg = *(const f32x4*)(gvec + c);
            if (FINAL) { gs[j] = gg; sh[j] = (f32x4){0.f, 0.f, 0.f, 0.f}; }
            else { const float* shift = mod + (size_t)b * NMODC + (sub * 3 + 0) * D; gs[j] = gg * (*(const f32x4*)(shift + D + c) + 1.0f); sh[j] = *(const f32x4*)(shift + c); }
            if (HASD) gt[j] = *(const f32x4*)(gate0 + (size_t)b * NMODC + c) * s; }
        f32x4 v[4], nx[4], nx2[4]; u32x2 dl[4], nd[4], nd2[4];
        { const f32x4* xr = (const f32x4*)(Xin + (size_t)r0 * D) + lane; const u32x2* dr = (const u32x2*)(delta + (size_t)r0 * D) + lane;
#pragma unroll
          for (int j = 0; j < 4; ++j) { v[j] = __builtin_nontemporal_load(xr + 64 * j); if (HASD) dl[j] = __builtin_nontemporal_load(dr + 64 * j); }
#pragma unroll
          for (int j = 0; j < 4; ++j) { nx[j] = __builtin_nontemporal_load(xr + 64 * j + D / 4); if (HASD) nd[j] = __builtin_nontemporal_load(dr + 64 * j + D / 4); } }
        for (int r = r0; r < r0 + 16; ++r) {
            if (r + 2 < r0 + 16) { const f32x4* xr = (const f32x4*)(Xin + (size_t)(r + 2) * D) + lane; const u32x2* dr = (const u32x2*)(delta + (size_t)(r + 2) * D) + lane;
#pragma unroll
                for (int j = 0; j < 4; ++j) { nx2[j] = __builtin_nontemporal_load(xr + 64 * j); if (HASD) nd2[j] = __builtin_nontemporal_load(dr + 64 * j); } }
            float ss = 0.f;
#pragma unroll
            for (int j = 0; j < 4; ++j) {
                if (HASD) { const f32x4 d = (f32x4){bflo(dl[j].x), bfhi(dl[j].x), bflo(dl[j].y), bfhi(dl[j].y)}; v[j] += gt[j] * d; }
                ss += (v[j].x * v[j].x + v[j].y * v[j].y) + (v[j].z * v[j].z + v[j].w * v[j].w); }
            const float rstd = 1.0f / sqrtf(wave_sum(ss) * (1.0f / D) + EPS);
            if (FINAL) { f32x4* xo = (f32x4*)(Xout + (size_t)r * D) + lane;
#pragma unroll
                for (int j = 0; j < 4; ++j) __builtin_nontemporal_store(v[j] * rstd * gs[j], xo + 64 * j); }
            else {
                if (WRX && !XOUTB) { f32x4* xo = (f32x4*)(Xout + (size_t)r * D) + lane;
#pragma unroll
                    for (int j = 0; j < 4; ++j) __builtin_nontemporal_store(v[j], xo + 64 * j); }
                if (WRX && XOUTB) { u32x2* xo = (u32x2*)((bf16_t*)Xout + (size_t)r * D) + lane;
#pragma unroll
                    for (int j = 0; j < 4; ++j) { u32x2 w; w.x = cvt_pk_bf16(v[j].x, v[j].y); w.y = cvt_pk_bf16(v[j].z, v[j].w); __builtin_nontemporal_store(w, xo + 64 * j); } }
                u32x2* o8 = (u32x2*)(Hout + (size_t)r * D) + lane;
#pragma unroll
                for (int j = 0; j < 4; ++j) { const f32x4 o = v[j] * rstd * gs[j] + sh[j]; u32x2 w; w.x = cvt_pk_bf16(o.x, o.y); w.y = cvt_pk_bf16(o.z, o.w); o8[64 * j] = w; } }
#pragma unroll
            for (int j = 0; j < 4; ++j) { v[j] = nx[j]; nx[j] = nx2[j]; if (HASD) { dl[j] = nd[j]; nd[j] = nd2[j]; } }
        }
    }
}

__device__ __forceinline__ void norm_mod_phase(const float* X, const float* gvec, const float* mod, int sub, bf16_t* Hout, int gw, int ngw, int lane) {
    for (int blk = gw; blk < M / 16; blk += ngw) {
        const int r0 = blk * 16, b = r0 / SEQ;
        const float* shift = mod + (size_t)b * NMODC + (sub * 3 + 0) * D; const float* scale = shift + D;
        f32x4 gs[4], sh[4];
#pragma unroll
        for (int j = 0; j < 4; ++j) { const int c = 4 * lane + 256 * j; const f32x4 gg = *(const f32x4*)(gvec + c), sc = *(const f32x4*)(scale + c); gs[j] = gg * (sc + 1.0f); sh[j] = *(const f32x4*)(shift + c); }
        f32x4 v[4], nx[4];
        { const f32x4* xr = (const f32x4*)(X + (size_t)r0 * D) + lane;
#pragma unroll
          for (int j = 0; j < 4; ++j) v[j] = xr[64 * j]; }
        for (int r = r0; r < r0 + 16; ++r) {
            if (r + 1 < r0 + 16) { const f32x4* xr = (const f32x4*)(X + (size_t)(r + 1) * D) + lane;
#pragma unroll
                for (int j = 0; j < 4; ++j) nx[j] = xr[64 * j]; }
            float s = 0.f;
#pragma unroll
            for (int j = 0; j < 4; ++j) s += (v[j].x * v[j].x + v[j].y * v[j].y) + (v[j].z * v[j].z + v[j].w * v[j].w);
            const float rstd = 1.0f / sqrtf(wave_sum(s) * (1.0f / D) + EPS);
            u32x2* o8 = (u32x2*)(Hout + (size_t)r * D) + lane;
#pragma unroll
            for (int j = 0; j < 4; ++j) { const f32x4 o = v[j] * rstd * gs[j] + sh[j]; u32x2 w; w.x = cvt_pk_bf16(o.x, o.y); w.y = cvt_pk_bf16(o.z, o.w); o8[64 * j] = w; }
#pragma unroll
            for (int j = 0; j < 4; ++j) v[j] = nx[j];
        }
    }
}

__device__ __forceinline__ void resid_xg_pass(const float* Xin, const bf16_t* delta, const float* gate0, float s, float* Xout, const float* gvec, const float* mod, int sub, bf16_t* Hout, float* rss, int gw, int ngw, int lane) {
    for (int blk = gw; blk < M / 16; blk += ngw) {
        const int r0 = blk * 16, b = r0 / SEQ;
        f32x4 gs[4], gt[4];
#pragma unroll
        for (int j = 0; j < 4; ++j) { const int c = 4 * lane + 256 * j; const float* shift = mod + (size_t)b * NMODC + (sub * 3 + 0) * D;
            gs[j] = *(const f32x4*)(gvec + c) * (*(const f32x4*)(shift + D + c) + 1.0f); gt[j] = *(const f32x4*)(gate0 + (size_t)b * NMODC + c) * s; }
        f32x4 v[4], nx[4], nx2[4]; u32x2 dl[4], nd[4], nd2[4];
        { const f32x4* xr = (const f32x4*)(Xin + (size_t)r0 * D) + lane; const u32x2* dr = (const u32x2*)(delta + (size_t)r0 * D) + lane;
#pragma unroll
          for (int j = 0; j < 4; ++j) { v[j] = __builtin_nontemporal_load(xr + 64 * j); dl[j] = __builtin_nontemporal_load(dr + 64 * j); }
#pragma unroll
          for (int j = 0; j < 4; ++j) { nx[j] = __builtin_nontemporal_load(xr + 64 * j + D / 4); nd[j] = __builtin_nontemporal_load(dr + 64 * j + D / 4); } }
        for (int r = r0; r < r0 + 16; ++r) {
            if (r + 2 < r0 + 16) { const f32x4* xr = (const f32x4*)(Xin + (size_t)(r + 2) * D) + lane; const u32x2* dr = (const u32x2*)(delta + (size_t)(r + 2) * D) + lane;
#pragma unroll
                for (int j = 0; j < 4; ++j) { nx2[j] = __builtin_nontemporal_load(xr + 64 * j); nd2[j] = __builtin_nontemporal_load(dr + 64 * j); } }
            float ss = 0.f;
#pragma unroll
            for (int j = 0; j < 4; ++j) { const f32x4 d = (f32x4){bflo(dl[j].x), bfhi(dl[j].x), bflo(dl[j].y), bfhi(dl[j].y)}; v[j] += gt[j] * d;
                ss += (v[j].x * v[j].x + v[j].y * v[j].y) + (v[j].z * v[j].z + v[j].w * v[j].w); }
            ss = wave_sum(ss);
            if (lane < 16) rss[(size_t)r * 16 + lane] = (lane == 0) ? ss : 0.f;
            f32x4* xo = (f32x4*)(Xout + (size_t)r * D) + lane; u32x2* o8 = (u32x2*)(Hout + (size_t)r * D) + lane;
#pragma unroll
            for (int j = 0; j < 4; ++j) { __builtin_nontemporal_store(v[j], xo + 64 * j); const f32x4 o = v[j] * gs[j]; u32x2 w; w.x = cvt_pk_bf16(o.x, o.y); w.y = cvt_pk_bf16(o.z, o.w); o8[64 * j] = w; }
#pragma unroll
            for (int j = 0; j < 4; ++j) { v[j] = nx[j]; nx[j] = nx2[j]; dl[j] = nd[j]; nd[j] = nd2[j]; }
        }
    }
}

template <int W> __device__ __forceinline__ void zpass_group(const bf16_t* UP, bf16_t* Z, int tb, int k, int lane) {
    const int cl = lane & 15, tq = lane >> 4;
    const int t0 = tb * 16 + tq * 4, tin = t0 & (SEQ - 1), c0 = k * 128 + cl * 8;
    constexpr int NR = W + 3;
    u32x4 rows[NR];
#pragma unroll
    for (int j = 0; j < NR; ++j) { const int dt = j - (W - 1);
        rows[j] = (tin + dt >= 0) ? *(const u32x4*)(UP + (size_t)(t0 + dt) * PWID + c0) : (u32x4){0u, 0u, 0u, 0u}; }
    f32x4 s0 = (f32x4){0.f, 0.f, 0.f, 0.f}, s1 = s0;
#pragma unroll
    for (int j = 0; j < W; ++j) { f32x4 a0, a1; pg8::unpack8(rows[j], a0, a1); s0 += a0; s1 += a1; }
#pragma unroll
    for (int i = 0; i < 4; ++i) {
        f32x4 c0v, c1v; pg8::unpack8(rows[W - 1 + i], c0v, c1v);
        if (i > 0) { f32x4 o0, o1; pg8::unpack8(rows[i - 1], o0, o1); s0 += c0v - o0; s1 += c1v - o1; }
        const int cnt = (tin + i + 1 < W) ? (tin + i + 1) : W; const float inv = 1.0f / (float)cnt;
        *(u32x4*)(Z + (size_t)(t0 + i) * PWID + c0) = pg8::pack8(s0 * inv - c0v, s1 * inv - c1v);
    }
}

__device__ __forceinline__ void final_pass_bf16x(const bf16_t* Xb, const bf16_t* delta, const float* gate0, float s, float* out, const float* gvec, int blk, int lane) {
    const int r0 = blk * 16, b = r0 / SEQ;
    f32x4 gs[4], gt[4];
#pragma unroll
    for (int j = 0; j < 4; ++j) { const int c = 4 * lane + 256 * j; gs[j] = *(const f32x4*)(gvec + c); gt[j] = *(const f32x4*)(gate0 + (size_t)b * NMODC + c) * s; }
    u32x2 xa[4], xn1[4], xn2[4], da[4], dn1[4], dn2[4];
    { const u32x2* xr = (const u32x2*)(Xb + (size_t)r0 * D) + lane; const u32x2* dr = (const u32x2*)(delta + (size_t)r0 * D) + lane;
#pragma unroll
      for (int j = 0; j < 4; ++j) { xa[j] = __builtin_nontemporal_load(xr + 64 * j); da[j] = __builtin_nontemporal_load(dr + 64 * j); }
#pragma unroll
      for (int j = 0; j < 4; ++j) { xn1[j] = __builtin_nontemporal_load(xr + 64 * j + D / 4); dn1[j] = __builtin_nontemporal_load(dr + 64 * j + D / 4); } }
    for (int r = r0; r < r0 + 16; ++r) {
        if (r + 2 < r0 + 16) { const u32x2* xr = (const u32x2*)(Xb + (size_t)(r + 2) * D) + lane; const u32x2* dr = (const u32x2*)(delta + (size_t)(r + 2) * D) + lane;
#pragma unroll
            for (int j = 0; j < 4; ++j) { xn2[j] = __builtin_nontemporal_load(xr + 64 * j); dn2[j] = __builtin_nontemporal_load(dr + 64 * j); } }
        f32x4 v[4]; float ss = 0.f;
#pragma unroll
        for (int j = 0; j < 4; ++j) { const f32x4 x = (f32x4){bflo(xa[j].x), bfhi(xa[j].x), bflo(xa[j].y), bfhi(xa[j].y)}, d = (f32x4){bflo(da[j].x), bfhi(da[j].x), bflo(da[j].y), bfhi(da[j].y)};
            v[j] = x + gt[j] * d; ss += (v[j].x * v[j].x + v[j].y * v[j].y) + (v[j].z * v[j].z + v[j].w * v[j].w); }
        const float rstd = 1.0f / sqrtf(wave_sum(ss) * (1.0f / D) + EPS);
        f32x4* xo = (f32x4*)(out + (size_t)r * D) + lane;
#pragma unroll
        for (int j = 0; j < 4; ++j) __builtin_nontemporal_store(v[j] * rstd * gs[j], xo + 64 * j);
#pragma unroll
        for (int j = 0; j < 4; ++j) { xa[j] = xn1[j]; xn1[j] = xn2[j]; da[j] = dn1[j]; dn1[j] = dn2[j]; }
    }
}

constexpr int LDS_BYTES = 163840;
constexpr int LDS_RSTD = 131072 + 1024, LDS_SWT = LDS_RSTD + 11 * 1024, MAXU = 11;
template <class Sched> __device__ __forceinline__ void fill_norm_tables(LAS unsigned char* lds, const Sched& S, const float* rss, const float* sW, int nw, int tid) {
    LAS float* rstdL = (LAS float*)(lds + LDS_RSTD); LAS float* swL = (LAS float*)(lds + LDS_SWT);
    constexpr int NU = 6;
    pg8::Unit u[NU]; bool ok[NU]; f32x4 q[NU]; float sv[NU];
#pragma unroll
    for (int ui = 0; ui < NU; ++ui) { ok[ui] = S.next(ui, u[ui]); q[ui] = (f32x4){0.f, 0.f, 0.f, 0.f}; sv[ui] = 0.f;
        if (ok[ui]) { if (tid < 256) { const f32x4* p = (const f32x4*)(rss + (size_t)(u[ui].pm * 256 + tid) * 16); q[ui] = (p[0] + p[1]) + (p[2] + p[3]); }
                      else sv[ui] = sW[(size_t)(u[ui].pm >> 4) * nw + u[ui].pn * 256 + tid - 256]; } }
#pragma unroll
    for (int ui = 0; ui < NU; ++ui) if (ok[ui]) { if (tid < 256) rstdL[ui * 256 + tid] = 1.0f / sqrtf(((q[ui].x + q[ui].y) + (q[ui].z + q[ui].w)) * (1.0f / D) + EPS); else swL[ui * 256 + tid - 256] = sv[ui]; }
    __syncthreads();
}

__global__ void __launch_bounds__(512, 2) mega_fwd(Args a) {
    extern __shared__ __attribute__((aligned(16))) unsigned char lds_raw[];
    LAS unsigned char* lds = (LAS unsigned char*)lds_raw;
    cg::grid_group grid = cg::this_grid();
    const int G = gridDim.x, bid = blockIdx.x, ngw = G * 8;
#define PHASE_IDS int tid = threadIdx.x; asm volatile("" : "+v"(tid)); const int lane = tid & 63, wave = __builtin_amdgcn_readfirstlane(tid >> 6), gw = bid * 8 + wave; \
    LAS float* scr = (LAS float*)(lds + wave * 16384); (void)lane; (void)gw; (void)scr;
#define x_in (a.in[0])
#define X (a.out)
#define mod ((float*)(a.ws + WS_MOD))
#define part ((float*)(a.ws + WS_PART))
#define W1IN ((bf16_t*)(a.ws + WS_W1IN))
#define W1OUT ((bf16_t*)(a.ws + WS_W1OUT))
#define WIN ((bf16_t*)(a.ws + WS_WIN))
#define WPOOL ((bf16_t*)(a.ws + WS_WPOOL))
#define WPUP ((bf16_t*)(a.ws + WS_WPUP))
#define WGLU ((bf16_t*)(a.ws + WS_WGLU))
#define WSUP ((bf16_t*)(a.ws + WS_WSUP))
#define WOUT ((bf16_t*)(a.ws + WS_WOUT))
#define W2IN ((bf16_t*)(a.ws + WS_W2IN))
#define W2OUT ((bf16_t*)(a.ws + WS_W2OUT))
#define BTE ((bf16_t*)(a.ws + WS_BTE))
#define BTY ((bf16_t*)(a.ws + WS_BTY))
#define Hb ((bf16_t*)(a.ws + WS_H))
#define ACT ((bf16_t*)(a.ws + WS_ACT))
#define UPOOL ((bf16_t*)(a.ws + WS_UPOOL))
#define ASSM ((bf16_t*)(a.ws + WS_ASSM))
#define Zb ((bf16_t*)(a.ws + WS_Z))
#define ZP ((bf16_t*)(a.ws + WS_ZP))
#define Eb ((float*)(a.ws + WS_E))
#define YG ((bf16_t*)(a.ws + WS_YG))
#define SG ((bf16_t*)(a.ws + WS_SG))
#define SIGP ((bf16_t*)(a.ws + WS_SIGP))
#define SIGS ((bf16_t*)(a.ws + WS_SIGS))
#define MERGED Hb
#define DELTA SIGP
#define RSS ((float*)(a.ws + WS_RSS))
#define SWIN ((float*)(a.ws + WS_SW))
#define SW2 (SWIN + BATCH * 3072)
    volatile LAS unsigned* MISC = (volatile LAS unsigned*)(lds + 131072 + 320);
    if (threadIdx.x < 16) MISC[threadIdx.x] = 0u;
    __syncthreads();
    const XcdBarrier xbar = xcd_barrier_post((unsigned*)(a.ws + WS_BAR), MISC + 8);
#define GRID_BAR() xcd_barrier(xbar)

    { PHASE_IDS
    for (int w = bid; w < NG * 8; w += G) ssm_prep_stage1(a, w >> 3, w & 7, (LAS float*)lds, tid);
    {
        const float* cvec = a.in[1]; const float* w_ada = a.in[2];
        for (int it = bid + G * wave; it < MODKC * 36 && wave < 3; it += 3 * G) {
            const int kc = it / 36, cb = it % 36;
#pragma unroll
            for (int b = 0; b < BATCH; ++b) { const float v = cvec[b * D + kc * 64 + lane]; scr[b * 64 + lane] = v * sigm(v); }
            LDS_WAIT();
            f32x4 acc[BATCH];
#pragma unroll
            for (int b = 0; b < BATCH; ++b) acc[b] = (f32x4){0.f, 0.f, 0.f, 0.f};
            const float* wp = w_ada + (size_t)(kc * 64) * NMODC + cb * 256;
            const unsigned lo4 = (unsigned)lane * 4u;
#pragma unroll 8
            for (int k = 0; k < 64; ++k) { const f32x4 w = __builtin_nontemporal_load((const f32x4*)((wp + (size_t)k * NMODC) + lo4));
#pragma unroll
                for (int b = 0; b < BATCH; ++b) acc[b] += w * scr[b * 64 + k]; }
#pragma unroll
            for (int b = 0; b < BATCH; ++b) *(f32x4*)(part + (size_t)(kc * BATCH + b) * NMODC + cb * 256 + lane * 4) = acc[b];
            LDS_WAIT();
        }
    }
    {
        constexpr int I1 = (D / 64) * (2 * FF / 32), I2 = (FF / 64) * (D / 32), I3 = (D / 64) * (3072 / 32), I4 = 4 * 2 * 4, I5 = (512 / 64) * (D / 32), I8 = (D / 64) * (D / 32);
        constexpr int NIT = 2 * I1 + 2 * I2 + I3 + I4 + 3 * I5 + I8;
        const int nmod = (bid + 2 * G < MODKC * 36) ? 3 : ((bid + G < MODKC * 36) ? 2 : ((bid < MODKC * 36) ? 1 : 0));
        const int nper = (NIT - bid + G - 1) / G;
        const int J1 = (nmod >= 8) ? 0 : ((nper * (8 - nmod) * 13) / (8 * 13 - nmod * 8) < nper ? (nper * (8 - nmod) * 13) / (8 * 13 - nmod * 8) : nper);
        const bool ismod = wave < nmod;
        const int jstart = ismod ? J1 + wave : wave - nmod, jstep = ismod ? nmod : 8 - nmod, jend = ismod ? nper : J1;
        for (int j = jstart; j < jend; j += jstep) {
            const int it = bid + G * j;
            int r = it;
            if (r < I1) { transpose_item(a.in[5], D, 2 * FF, W1IN, FF, r, scr, lane); continue; } r -= I1;
            if (r < I1) { transpose_item(a.in[26], D, 2 * FF, W2IN, FF, r, scr, lane); continue; } r -= I1;
            if (r < I2) { transpose_item(a.in[6], FF, D, W1OUT, 0, r, scr, lane); continue; } r -= I2;
            if (r < I2) { transpose_item(a.in[27], FF, D, W2OUT, 0, r, scr, lane); continue; } r -= I2;
            if (r < I3) { transpose_item(a.in[8], D, 3072, WIN, 0, r, scr, lane); continue; } r -= I3;
            if (r < I4) { const int k = r >> 3, q = r & 7, kb = q >> 2, nb = q & 3;
                transpose_block(a.in[9] + (size_t)k * 128 * 128, 128, WPOOL + (size_t)(k * 128) * PWID + k * 128, PWID, 64 * kb, 32 * nb, 32 * nb, scr, lane); continue; } r -= I4;
            if (r < I5) { transpose_item(a.in[12], 512, D, WPUP, 0, r, scr, lane); continue; } r -= I5;
            if (r < I5) { transpose_item(a.in[21], 512, D, WGLU, 512, r, scr, lane); continue; } r -= I5;
            if (r < I5) { transpose_item(a.in[23], 512, D, WSUP, 0, r, scr, lane); continue; } r -= I5;
            transpose_item(a.in[24], D, D, WOUT, 0, r, scr, lane);
        }
        for (int q = bid * 512 + tid; q < 12 * 128 * 16; q += G * 512) { const int blk = q / 2048, rem = q % 2048, row = rem >> 4, ch = rem & 15;
            const int kr = blk / 3, kk = blk % 3, kc = kk + (kk >= kr ? 1 : 0);
            *(u32x4*)(WPOOL + (size_t)(kr * 128 + row) * PWID + kc * 128 + ch * 8) = (u32x4){0u, 0u, 0u, 0u}; }
    }
    }
    if (a.ws == nullptr) grid.sync();
    GRID_BAR();
    { PHASE_IDS
        const float* b_ada = a.in[3];
        {
            const int bb = bid >> 5;
            for (int i = tid; i < 2 * D; i += 512) { float s = b_ada[i];
#pragma unroll
                for (int kc = 0; kc < MODKC; ++kc) s += part[(size_t)(kc * BATCH + bb) * NMODC + i];
                mod[(size_t)bb * NMODC + i] = s; }
            for (int i = bid * 512 + tid; i < BATCH * NMODC; i += G * 512) { float s = b_ada[i % NMODC];
#pragma unroll
                for (int kc = 0; kc < MODKC; ++kc) s += part[(size_t)kc * BATCH * NMODC + i];
                mod[i] = s; }
            asm volatile("s_waitcnt vmcnt(0)" ::: "memory"); __syncthreads();
        }
        row_pass<false, false, false>(x_in, Hb, mod, 0.f, X, a.in[4], mod, 0, Hb, gw, ngw, lane);
        const float* KTg = (const float*)(a.ws + WS_KT);
        for (int q0 = bid * 512 + tid; q0 < NG * 512 * 64; q0 += 4 * G * 512) {
            f32x4 k0[4], k1[4];
#pragma unroll
            for (int e = 0; e < 4; ++e) { const int q = q0 + e * G * 512, g = q >> 15, row = (q >> 6) & 511, ch = q & 63, t = row >> 4, h = row & 15, s = ch >> 1, hp0 = (ch & 1) * 8;
                k0[e] = (f32x4){0.f, 0.f, 0.f, 0.f}; k1[e] = k0[e];
                if (t >= s) { const float* kp = KTg + (size_t)g * (CL * 256) + (t - s) * 256 + h * 16 + hp0; k0[e] = *(const f32x4*)kp; k1[e] = *(const f32x4*)(kp + 4); } }
#pragma unroll
            for (int e = 0; e < 4; ++e) { const int q = q0 + e * G * 512, g = q >> 15, row = (q >> 6) & 511, ch = q & 63, s = ch >> 1, hp0 = (ch & 1) * 8;
                *(u32x4*)(BTY + ((size_t)(g * 512 + row) * KA + s * GH + hp0)) = pg8::pack8(k0[e], k1[e]); } }
    }
    GRID_BAR();
    {
        pg8::Gemm g{Hb, W1IN, D, D, D, 0}; pg8::StaticOrder S; S.init(M, 2 * FF, G, bid);
        pg8::EpiSwiGLU<false> E{ACT, FF, nullptr, nullptr};
        pg8::gemm_phase<pg8::EpiSwiGLU<false>, pg8::StaticOrder, true>(lds, g, S, E);
    }
    GRID_BAR();
    {
        pg8::Gemm g{ACT, W1OUT, FF, FF, FF, 0}; pg8::StaticOrder S; S.init(M, D, G, bid);
        pg8::EpiPlain E{DELTA, D};
        pg8::gemm_phase<pg8::EpiPlain, pg8::StaticOrder, true>(lds, g, S, E);
    }
    GRID_BAR();
    { PHASE_IDS
    {
        for (int row = gw; row < 3072; row += ngw) {
            const bf16_t* wrow = WIN + (size_t)row * D;
            f32x4 w[4]; { f32x4 t0, t1; pg8::unpack8(*(const u32x4*)(wrow + 8 * lane), t0, t1); w[0] = t0; w[1] = t1; pg8::unpack8(*(const u32x4*)(wrow + 512 + 8 * lane), t0, t1); w[2] = t0; w[3] = t1; }
            f32x4 sh4[BATCH][4];
#pragma unroll
            for (int b = 0; b < BATCH; ++b) { const float* sh = mod + (size_t)b * NMODC + (1 * 3 + 0) * D;
                sh4[b][0] = *(const f32x4*)(sh + 8 * lane); sh4[b][1] = *(const f32x4*)(sh + 8 * lane + 4); sh4[b][2] = *(const f32x4*)(sh + 512 + 8 * lane); sh4[b][3] = *(const f32x4*)(sh + 512 + 8 * lane + 4); }
#pragma unroll
            for (int b = 0; b < BATCH; ++b) { const f32x4 pr = (w[0] * sh4[b][0] + w[1] * sh4[b][1]) + (w[2] * sh4[b][2] + w[3] * sh4[b][3]);
                const float tot = wave_sum((pr.x + pr.y) + (pr.z + pr.w));
                if (lane == 0) SWIN[(size_t)b * 3072 + row] = tot; }
        }
    }
    resid_xg_pass(x_in, DELTA, mod + (0 * 3 + 2) * D, 0.5f, X, a.in[7], mod, 1, Hb, RSS, (bid & 7) * 256 + (bid >> 3) * 8 + wave, ngw, lane);
    }
    GRID_BAR();
    {
        pg8::Gemm g{Hb, WIN, D, D, D, 0}; pg8::StaticOrder S; S.init(M, 3072, G, bid);
        { PHASE_IDS fill_norm_tables(lds, S, RSS, SWIN, 3072, tid); }
        pg8::EpiWin E{UPOOL, ASSM, SIGP, SIGS, (const LAS float*)(lds + LDS_RSTD), (const LAS float*)(lds + LDS_SWT)};
        pg8::gemm_phase<pg8::EpiWin, pg8::StaticOrder, true>(lds, g, S, E);
    }
    GRID_BAR();
    {
        { PHASE_IDS
        const int slot = bid >> 3;
        if (G == 256 && slot >= 16) { const int widx = (slot - 16) * 8 + (bid & 7);
#pragma unroll
            for (int j = 0; j < 8; ++j) { const int tb = widx * 16 + wave + 8 * (j & 1);
                if ((j >> 1) == 0) zpass_group<2>(UPOOL, Zb, tb, 0, lane); else if ((j >> 1) == 1) zpass_group<4>(UPOOL, Zb, tb, 1, lane); else if ((j >> 1) == 2) zpass_group<8>(UPOOL, Zb, tb, 2, lane); else zpass_group<16>(UPOOL, Zb, tb, 3, lane); }
            asm volatile("s_waitcnt vmcnt(0)" ::: "memory"); __syncthreads(); } }
        pg8::Gemm g{ASSM, BTE, KA, 512, 512, 0}; pg8::OrderE S{G, bid};
        pg8::EpiEC E{ASSM, (const float*)(a.ws + WS_A32)};
        pg8::gemm_phase<pg8::EpiEC, pg8::OrderE, false>(lds, g, S, E);
        {
            pg8::Gemm g2{Zb, WPOOL, PWID, PWID, 256, 256 * 2};
            pg8::OrderP1 S2{G, bid}; pg8::EpiPool1 E2{ZP, a.in[10], a.in[11]};
            pg8::gemm_phase<pg8::EpiPool1, pg8::OrderP1, false>(lds, g2, S2, E2);
        }
    }
    GRID_BAR();
    {
        { pg8::Gemm g{ASSM, BTY, KA, KA, KA, 0}; pg8::OrderY S{G, bid}; pg8::EpiY E{YG, ASSM, a.in[20]};
          pg8::gemm_phase<pg8::EpiY, pg8::OrderY, false>(lds, g, S, E); }
        { pg8::Gemm g{ZP, WPUP, PWID, PWID, PWID, 0}; pg8::StaticOrder S; S.init(M, D, G, bid); pg8::EpiGateAcc<false> E{MERGED, SIGP};
          pg8::gemm_phase<pg8::EpiGateAcc<false>, pg8::StaticOrder, true>(lds, g, S, E); }
    }
    GRID_BAR();
    {
        pg8::Gemm g{YG, WGLU, SWID, SWID, SWID, 0}; pg8::StaticOrder S; S.init(M, 2 * SWID, G, bid);
        pg8::EpiGLU E{SG, SWID, a.in[22], SWID};
        pg8::gemm_phase<pg8::EpiGLU, pg8::StaticOrder, true>(lds, g, S, E);
    }
    GRID_BAR();
    {
        pg8::Gemm g{SG, WSUP, SWID, SWID, SWID, 0}; pg8::StaticOrder S; S.init(M, D, G, bid);
        pg8::EpiGateAcc<true> E{MERGED, SIGS};
        pg8::gemm_phase<pg8::EpiGateAcc<true>, pg8::StaticOrder, true>(lds, g, S, E);
    }
    GRID_BAR();
    {
        pg8::Gemm g{MERGED, WOUT, D, D, D, 0}; pg8::StaticOrder S; S.init(M, D, G, bid);
        pg8::EpiPlain E{DELTA, D};
        pg8::gemm_phase<pg8::EpiPlain, pg8::StaticOrder, true>(lds, g, S, E);
    }
    GRID_BAR();
    { PHASE_IDS
    row_pass<true, true, false, true>(X, DELTA, mod + (1 * 3 + 2) * D, 1.0f, (float*)SIGS  , a.in[25], mod, 2, Hb, (bid & 7) * 256 + (bid >> 3) * 8 + wave, ngw, lane);
    }
    GRID_BAR();
    {
        pg8::Gemm g{Hb, W2IN, D, D, D, 0}; pg8::StaticOrder S; S.init(M, 2 * FF, G, bid);
        pg8::EpiSwiGLU<false> E{ACT, FF, nullptr, nullptr};
        pg8::gemm_phase<pg8::EpiSwiGLU<false>, pg8::StaticOrder, true>(lds, g, S, E);
    }
    GRID_BAR();
    {
        pg8::Gemm g{ACT, W2OUT, FF, FF, FF, 0}; pg8::StaticOrder S; S.init(M, D, G, bid);
        pg8::EpiPlain E{DELTA, D};
        pg8::gemm_phase<pg8::EpiPlain, pg8::StaticOrder, true>(lds, g, S, E);
    }
    GRID_BAR();
    { PHASE_IDS
    final_pass_bf16x(SIGS, DELTA, mod + (2 * 3 + 2) * D, 0.5f, X, a.in[28], (bid & 7) * 256 + (bid >> 3) * 8 + wave, lane);
    }
}

extern "C" void kernel_launch(void* const* d_in, const int* in_sizes, int n_in, void* d_out, int out_size, void* d_ws, size_t ws_size, hipStream_t stream) {
    static int grid_blocks = 0;
    if (grid_blocks == 0) {
        if (n_in != 29 || out_size != M * D || ws_size < WS_END) { fprintf(stderr, "kernel_launch: unexpected problem (n_in %d out %d ws %zu)\n", n_in, out_size, ws_size); grid_blocks = -1; return; }
        int dev = 0, cus = 0, per_cu = 0;
        (void)hipGetDevice(&dev);
        (void)hipDeviceGetAttribute(&cus, hipDeviceAttributeMultiprocessorCount, dev);
        (void)hipFuncSetAttribute((const void*)mega_fwd, hipFuncAttributeMaxDynamicSharedMemorySize, LDS_BYTES);
        (void)hipOccupancyMaxActiveBlocksPerMultiprocessor(&per_cu, (const void*)mega_fwd, 512, LDS_BYTES);
        (void)hipGetLastError();
        if (per_cu < 1) per_cu = 1;
        grid_blocks = cus * per_cu;
        if (grid_blocks != 256) { fprintf(stderr, "kernel_launch: built for a 256-workgroup grid (got %d)\n", grid_blocks); grid_blocks = -1; return; }
    }
    if (grid_blocks < 0) return;
    Args a{};
    for (int i = 0; i < 29; ++i) a.in[i] = (const float*)d_in[i];
    a.out = (float*)d_out; a.ws = (unsigned char*)d_ws;
    (void)hipMemsetAsync((unsigned char*)d_ws + WS_BAR, 0, BAR_BYTES, stream);
    void* args[] = {&a};
    hipError_t e = hipLaunchCooperativeKernel((const void*)mega_fwd, dim3(grid_blocks), dim3(512), args, LDS_BYTES, stream);
    if (e != hipSuccess) fprintf(stderr, "cooperative launch failed: %s (grid %d)\n", hipGetErrorString(e), grid_blocks);
}
```
